# Optimizing an MI355X kernel written in HIP

```python
import math
import jax, jax.numpy as jnp
from jax import lax
import numpy as np

D_MODEL = 2048
BATCH = 8
SEQ = 2048
DEPTH = 1

HEAD_DIM = 128
FOX_HEADS = 8
MOBA_HEADS = 4
MEM_HEADS = 4
FOX_W = FOX_HEADS * HEAD_DIM
MOBA_W = MOBA_HEADS * HEAD_DIM
MEM_W = MEM_HEADS * HEAD_DIM
MIX_W = FOX_W + MOBA_W + MEM_W
IN_W = 3 * FOX_W + FOX_HEADS + 3 * MOBA_W + MEM_W
D_FF = 5632
N_MEM = 256
FOX_Q_BLOCK = 128
MOBA_BLOCK = 256
MOBA_TOPK = 3
MOBA_Q_CHUNK = 32
REL_BUCKETS = 32
REL_MAX_DIST = 128
EPS = 1e-6
NEG = -1e30

kernel_name = "hymba_fox_moba_macaron_layer"


def rmsnorm(x, g):
    xf = x.astype(jnp.float32)
    y = xf * lax.rsqrt(jnp.mean(xf * xf, axis=-1, keepdims=True) + EPS)
    return (y * g.astype(jnp.float32)).astype(x.dtype)


def swiglu(h, w1, w3, w2):
    return (jax.nn.silu(h @ w1) * (h @ w3)) @ w2


def t5_bucket(dist):
    n = jnp.maximum(dist, 0)
    max_exact = REL_BUCKETS // 2
    nf = jnp.maximum(n, 1).astype(jnp.float32)
    large = max_exact + (jnp.log(nf / max_exact) / math.log(REL_MAX_DIST / max_exact)
                         * (REL_BUCKETS - max_exact)).astype(jnp.int32)
    large = jnp.minimum(large, REL_BUCKETS - 1)
    return jnp.where(n < max_exact, n, large)


def fox_attention(q, k, v, logf):
    B, H, S, Dh = q.shape
    c = jnp.cumsum(logf, axis=-1)
    kpos = jnp.arange(S)
    scale = Dh ** -0.5

    def block(i):
        s0 = i * FOX_Q_BLOCK
        qb = lax.dynamic_slice_in_dim(q, s0, FOX_Q_BLOCK, axis=2)
        cb = lax.dynamic_slice_in_dim(c, s0, FOX_Q_BLOCK, axis=2)
        qpos = s0 + jnp.arange(FOX_Q_BLOCK)
        logits = (jnp.einsum('bhqd,bhkd->bhqk', qb, k).astype(jnp.float32) * scale
                  + cb[..., :, None] - c[..., None, :])
        logits = jnp.where(kpos[None, :] <= qpos[:, None], logits, NEG)
        p = jax.nn.softmax(logits, axis=-1).astype(v.dtype)
        return jnp.einsum('bhqk,bhkd->bhqd', p, v)

    out = lax.map(block, jnp.arange(S // FOX_Q_BLOCK))
    return jnp.moveaxis(out, 0, 2).reshape(B, H, S, Dh)


def moba_attention(q, k, v, rel_bias):
    B, H, S, Dh = q.shape
    nb = -(-S // MOBA_BLOCK)
    pad = nb * MOBA_BLOCK - S
    kp = jnp.pad(k, ((0, 0), (0, 0), (0, pad), (0, 0)))
    vp = jnp.pad(v, ((0, 0), (0, 0), (0, pad), (0, 0)))
    kb = kp.reshape(B, H, nb, MOBA_BLOCK, Dh)
    vb = vp.reshape(B, H, nb, MOBA_BLOCK, Dh)
    kmean = jnp.mean(kb.astype(jnp.float32), axis=3)
    topk = min(MOBA_TOPK, nb)
    scale = Dh ** -0.5
    b_i = jnp.arange(B)[:, None, None, None]
    h_i = jnp.arange(H)[None, :, None, None]
    h_i5 = jnp.arange(H)[None, :, None, None, None]
    blk_ids = jnp.arange(nb)
    offs = jnp.arange(MOBA_BLOCK)

    def chunk(i):
        s0 = i * MOBA_Q_CHUNK
        qc = lax.dynamic_slice_in_dim(q, s0, MOBA_Q_CHUNK, axis=2)
        qpos = s0 + jnp.arange(MOBA_Q_CHUNK)
        own = s0 // MOBA_BLOCK
        gate = jnp.einsum('bhqd,bhnd->bhqn', qc.astype(jnp.float32), kmean)
        gate = jnp.where(blk_ids < own, gate, NEG)
        _, idx = lax.top_k(gate, topk)
        sel_valid = idx < own
        ksel = kb[b_i, h_i, idx]
        vsel = vb[b_i, h_i, idx]
        sel_pos = idx[..., None] * MOBA_BLOCK + offs
        l_sel = jnp.einsum('bhqd,bhqnkd->bhqnk', qc, ksel).astype(jnp.float32) * scale
        l_sel = l_sel + rel_bias[t5_bucket(qpos[:, None, None] - sel_pos), h_i5].astype(jnp.float32)
        l_sel = jnp.where(sel_valid[..., None], l_sel, NEG)
        l_sel = l_sel.reshape(B, H, MOBA_Q_CHUNK, topk * MOBA_BLOCK)
        own_start = own * MOBA_BLOCK
        kown = lax.dynamic_slice_in_dim(kp, own_start, MOBA_BLOCK, axis=2)
        vown = lax.dynamic_slice_in_dim(vp, own_start, MOBA_BLOCK, axis=2)
        dist_own = qpos[:, None] - (own_start + offs)[None, :]
        l_own = jnp.einsum('bhqd,bhkd->bhqk', qc, kown).astype(jnp.float32) * scale
        l_own = l_own + jnp.moveaxis(rel_bias[t5_bucket(dist_own)], -1, 0).astype(jnp.float32)
        l_own = jnp.where(dist_own >= 0, l_own, NEG)
        p = jax.nn.softmax(jnp.concatenate([l_sel, l_own], axis=-1), axis=-1).astype(v.dtype)
        p_sel = p[..., :topk * MOBA_BLOCK].reshape(B, H, MOBA_Q_CHUNK, topk, MOBA_BLOCK)
        p_own = p[..., topk * MOBA_BLOCK:]
        return (jnp.einsum('bhqnk,bhqnkd->bhqd', p_sel, vsel)
                + jnp.einsum('bhqk,bhkd->bhqd', p_own, vown))

    out = lax.map(chunk, jnp.arange(S // MOBA_Q_CHUNK))
    return jnp.moveaxis(out, 0, 2).reshape(B, H, S, Dh)


def memory_attention(q, k, v):
    logits = jnp.einsum('bhqd,bhmd->bhqm', q, k).astype(jnp.float32) * (q.shape[-1] ** -0.5)
    p = jax.nn.softmax(logits, axis=-1).astype(v.dtype)
    return jnp.einsum('bhqm,bhmd->bhqd', p, v)


def setup_inputs(seed: int = 0) -> dict:
    key = jax.random.key(seed)
    ks = jax.random.split(key, 24)
    f32 = jnp.float32

    def nrm(k, shape, fan_in):
        return jax.random.normal(k, shape, f32) * (fan_in ** -0.5)

    def gain(k, shape):
        return 1.0 + 0.05 * jax.random.normal(k, shape, f32)

    L = DEPTH
    return {
        "x": jax.random.normal(ks[0], (BATCH, SEQ, D_MODEL), f32),
        "mem": jax.random.normal(ks[1], (BATCH, N_MEM, D_MODEL), f32),
        "ffn1_norm": gain(ks[2], (L, D_MODEL)),
        "ffn1_w1": nrm(ks[3], (L, D_MODEL, D_FF), D_MODEL),
        "ffn1_w3": nrm(ks[4], (L, D_MODEL, D_FF), D_MODEL),
        "ffn1_w2": nrm(ks[5], (L, D_FF, D_MODEL), D_FF),
        "mix_norm": gain(ks[6], (L, D_MODEL)),
        "mem_norm": gain(ks[7], (L, D_MODEL)),
        "w_in": nrm(ks[8], (L, D_MODEL, IN_W), D_MODEL),
        "b_forget": jax.random.uniform(ks[9], (L, FOX_HEADS), f32, 1.0, 3.0),
        "w_mem_kv": nrm(ks[10], (L, D_MODEL, 2 * MEM_W), D_MODEL),
        "fox_q_gain": gain(ks[11], (L, HEAD_DIM)),
        "fox_k_gain": gain(ks[12], (L, HEAD_DIM)),
        "moba_q_gain": gain(ks[13], (L, HEAD_DIM)),
        "moba_k_gain": gain(ks[14], (L, HEAD_DIM)),
        "mem_q_gain": gain(ks[15], (L, HEAD_DIM)),
        "mem_k_gain": gain(ks[16], (L, HEAD_DIM)),
        "w_out": nrm(ks[17], (L, MIX_W, D_MODEL), MIX_W),
        "ffn2_norm": gain(ks[18], (L, D_MODEL)),
        "ffn2_w1": nrm(ks[19], (L, D_MODEL, D_FF), D_MODEL),
        "ffn2_w3": nrm(ks[20], (L, D_MODEL, D_FF), D_MODEL),
        "ffn2_w2": nrm(ks[21], (L, D_FF, D_MODEL), D_FF),
        "rel_bias": 0.1 * jax.random.normal(ks[22], (REL_BUCKETS, MOBA_HEADS), f32),
    }


def reference(x, mem, ffn1_norm, ffn1_w1, ffn1_w3, ffn1_w2, mix_norm, mem_norm, w_in,
              b_forget, w_mem_kv, fox_q_gain, fox_k_gain, moba_q_gain, moba_k_gain,
              mem_q_gain, mem_k_gain, w_out, ffn2_norm, ffn2_w1, ffn2_w3, ffn2_w2, rel_bias):
    B, S, _ = x.shape
    M = mem.shape[1]
    splits = np.cumsum([FOX_W, FOX_W, FOX_W, FOX_HEADS, MOBA_W, MOBA_W, MOBA_W]).tolist()

    def heads(t, n_heads, length):
        return t.reshape(B, length, n_heads, HEAD_DIM).transpose(0, 2, 1, 3)

    for l in range(DEPTH):
        x = x + 0.5 * swiglu(rmsnorm(x, ffn1_norm[l]), ffn1_w1[l], ffn1_w3[l], ffn1_w2[l])

        h = rmsnorm(x, mix_norm[l])
        proj = h @ w_in[l]
        fq, fk, fv, ff, bq, bk, bv, cq = jnp.split(proj, splits, axis=-1)

        fq = rmsnorm(heads(fq, FOX_HEADS, S), fox_q_gain[l])
        fk = rmsnorm(heads(fk, FOX_HEADS, S), fox_k_gain[l])
        fv = heads(fv, FOX_HEADS, S)
        logf = jax.nn.log_sigmoid(ff.astype(jnp.float32)
                                  + b_forget[l].astype(jnp.float32)).transpose(0, 2, 1)
        o_fox = fox_attention(fq, fk, fv, logf)

        bq = rmsnorm(heads(bq, MOBA_HEADS, S), moba_q_gain[l])
        bk = rmsnorm(heads(bk, MOBA_HEADS, S), moba_k_gain[l])
        bv = heads(bv, MOBA_HEADS, S)
        o_moba = moba_attention(bq, bk, bv, rel_bias)

        cq = rmsnorm(heads(cq, MEM_HEADS, S), mem_q_gain[l])
        mkv = rmsnorm(mem, mem_norm[l]) @ w_mem_kv[l]
        ck, cv = jnp.split(mkv, 2, axis=-1)
        ck = rmsnorm(heads(ck, MEM_HEADS, M), mem_k_gain[l])
        cv = heads(cv, MEM_HEADS, M)
        o_mem = memory_attention(cq, ck, cv)

        o = jnp.concatenate([o_fox, o_moba, o_mem], axis=1)
        o = o.transpose(0, 2, 1, 3).reshape(B, S, MIX_W)
        x = x + o @ w_out[l]

        x = x + 0.5 * swiglu(rmsnorm(x, ffn2_norm[l]), ffn2_w1[l], ffn2_w3[l], ffn2_w2[l])
    return x
```

```cpp
#include <hip/hip_runtime.h>
#include <hip/hip_cooperative_groups.h>
#include <cstdio>
namespace cg = cooperative_groups;
namespace pg8 {
#define PG8_LAS __attribute__((address_space(3)))
typedef unsigned short bf16_t;
typedef short bf16x8 __attribute__((ext_vector_type(8)));
typedef float f32x4 __attribute__((ext_vector_type(4)));
typedef unsigned u32x4 __attribute__((ext_vector_type(4)));
constexpr int BM = 256, BK = 64, HALF = 128, HTB = HALF * BK * 2  , STAGE_BYTES = 8 * HTB, NXCD = 8, WGM = 6;

__host__ __device__ __forceinline__ int lds_byte(int r, int c) { const int st = (r >> 4) * 2 + (c >> 5), rr = r & 15, cc = c & 31, ob = rr * 64 + cc * 2; return st * 1024 + (ob ^ (((ob >> 9) & 1) << 5)); }
__host__ __device__ __forceinline__ void stage_rc(int b, int& R, int& C) { const int st = b / 1024, sb = b % 1024, swz = sb ^ (((sb >> 9) & 1) << 5); R = (st >> 1) * 16 + swz / 64; C = (st & 1) * 32 + (swz % 64) / 2; }
__host__ __device__ __forceinline__ int perm32(int rho) { const int n = rho >> 4, i = rho & 15; return 8 * (i >> 2) + 4 * n + (i & 3); }

struct Unit { int pm, pn; };
struct Gemm { const bf16_t* A; const bf16_t* Bt; int M, N, K; };

struct StaticOrder {
    int nM, nN, nwg, G, c;
    __host__ __device__ void init(int M, int N, int G_, int c_) { nM = M / BM; nN = N / BM; nwg = nM * nN; G = G_; c = c_; }
    __host__ __device__ bool next(int i, Unit& u) const {
        const long L = (long)i * G + c; if (L >= nwg) return false;
        int wgid = (int)L; { const int q = nwg / NXCD, r = nwg % NXCD, xcd = wgid % NXCD, off = wgid / NXCD; wgid = (xcd < r ? xcd * (q + 1) : r * (q + 1) + (xcd - r) * q) + off; }
        const int nig = WGM * nN, gid = wgid / nig, fm = gid * WGM, gsz = (nM - fm) < WGM ? (nM - fm) : WGM;
        u.pm = fm + ((wgid % nig) % gsz); u.pn = (wgid % nig) / gsz; return true;
    }
    __device__ __forceinline__ void a_ready(const Unit&) const {}
    __device__ __forceinline__ void done(const Unit&) const {}
};
__device__ __forceinline__ unsigned cvt_pk_bf16(float lo, float hi) { unsigned r; asm volatile("v_cvt_pk_bf16_f32 %0, %1, %2" : "=v"(r) : "v"(lo), "v"(hi)); return r; }
typedef float f32x2 __attribute__((ext_vector_type(2)));
template <class Epi, class Sched, bool ALIGN_EPI = false, bool SP2 = false>
__device__ __forceinline__ void gemm_phase(PG8_LAS unsigned char* lds, const Gemm g, const Sched& S, const Epi& E) {
    const int tid = threadIdx.x, wid = __builtin_amdgcn_readfirstlane(tid >> 6), lane = tid & 63, wr = wid >> 2, wc = wid & 3, fr = lane & 15, fq = lane >> 4;
    const int K = g.K, nt = K / BK;
    unsigned voffA[2], voffB[2];
#pragma unroll
    for (int i = 0; i < 2; ++i) { int R, C; stage_rc(tid * 16 + i * 8192, R, C); const int Rb = Epi::PERM ? ((R & ~31) + perm32(R & 31)) : R;
        voffA[i] = (unsigned)(R * K + C) * 2u; voffB[i] = (unsigned)(Rb * K + C) * 2u; }
    const size_t kstep = (size_t)(BK * 2);
    const size_t hstep = (size_t)HALF * K * 2;
    const size_t tstep = 2 * hstep;
    const unsigned ldsw = (unsigned)wid * 1024u;
    const int aoff = lds_byte(wr * 64 + fr, fq * 8), boff = lds_byte(wc * 32 + fr, fq * 8);
#define PG8_SA(b, h) (((b) * 2 + (h)) * HTB)
#define PG8_SB(b, h) ((4 + (b) * 2 + (h)) * HTB)
#define PG8_STAGE(bufoff, gbase, voff) do { _Pragma("unroll") for (int _i = 0; _i < 2; ++_i) \
        __builtin_amdgcn_global_load_lds((const unsigned*)((const char*)(gbase) + (voff)[_i]), (PG8_LAS unsigned*)(lds + (bufoff) + ldsw + _i * 8192), 16, 0, 0); } while (0)
#define PG8_LDA(dst, b, h) do { _Pragma("unroll") for (int m = 0; m < 4; ++m) _Pragma("unroll") for (int k = 0; k < 2; ++k) dst[m][k] = *(const PG8_LAS bf16x8*)(lds + PG8_SA(b, h) + aoff + m * 2048 + k * 1024); } while (0)
#define PG8_LDB(dst, b, h) do { _Pragma("unroll") for (int n = 0; n < 2; ++n) _Pragma("unroll") for (int k = 0; k < 2; ++k) dst[n][k] = *(const PG8_LAS bf16x8*)(lds + PG8_SB(b, h) + boff + n * 2048 + k * 1024); } while (0)
#define PG8_MMA(ai, bj, At, Bt) do { __builtin_amdgcn_s_setprio(1); _Pragma("unroll") for (int m = 0; m < 4; ++m) _Pragma("unroll") for (int n = 0; n < 2; ++n) _Pragma("unroll") for (int k = 0; k < 2; ++k) \
        acc[ai][bj][m][n] = __builtin_amdgcn_mfma_f32_16x16x32_bf16(Bt[n][k], At[m][k], acc[ai][bj][m][n], 0, 0, 0); __builtin_amdgcn_s_setprio(0); } while (0)
#define PG8_WAIT_V(n) asm volatile("s_waitcnt vmcnt(" #n ")" ::: "memory")
#define PG8_WAIT_L(n) asm volatile("s_waitcnt lgkmcnt(" #n ")" ::: "memory")
#define PG8_BAR __builtin_amdgcn_s_barrier()
#define PG8_SCHED __builtin_amdgcn_sched_barrier(0)
    Unit cur, nxt; int ui = 0;
    if (!S.next(0, cur)) return;
    f32x4 acc[2][2][4][2];
#pragma unroll
    for (int a = 0; a < 2; ++a)
#pragma unroll
        for (int b = 0; b < 2; ++b)
#pragma unroll
            for (int m = 0; m < 4; ++m)
#pragma unroll
                for (int n = 0; n < 2; ++n) acc[a][b][m][n] = (f32x4){0.f, 0.f, 0.f, 0.f};
    bf16x8 At[4][2], B0[2][2], B1[2][2];
    const char* cA = (const char*)g.A + (size_t)cur.pm * tstep; const char* cB = (const char*)g.Bt + (size_t)cur.pn * tstep;
    S.a_ready(cur);
    if constexpr (SP2) {
        PG8_STAGE(PG8_SB(0, 0), cB, voffB); PG8_STAGE(PG8_SB(0, 1), cB + hstep, voffB); PG8_STAGE(PG8_SA(0, 0), cA, voffA); PG8_STAGE(PG8_SA(0, 1), cA + hstep, voffA);
        if (wr == 1) PG8_BAR;
        PG8_WAIT_V(2); PG8_BAR;
        PG8_STAGE(PG8_SB(1, 0), cB + kstep, voffB); PG8_STAGE(PG8_SA(1, 0), cA + kstep, voffA); PG8_STAGE(PG8_SB(1, 1), cB + hstep + kstep, voffB);
        PG8_WAIT_V(6); PG8_BAR;
    } else {
        PG8_STAGE(PG8_SB(0, 0), cB, voffB); PG8_STAGE(PG8_SA(0, 0), cA, voffA); PG8_STAGE(PG8_SB(0, 1), cB + hstep, voffB); PG8_STAGE(PG8_SA(0, 1), cA + hstep, voffA);
        if (wr == 1) PG8_BAR;
        PG8_WAIT_V(4); PG8_BAR;
        PG8_STAGE(PG8_SB(1, 0), cB + kstep, voffB); PG8_STAGE(PG8_SA(1, 0), cA + kstep, voffA); PG8_STAGE(PG8_SB(1, 1), cB + hstep + kstep, voffB);
        PG8_WAIT_V(6); PG8_BAR;
    }
    for (;;) {
        const bool has_next = S.next(ui + 1, nxt);
        const char* nA = has_next ? (const char*)g.A + (size_t)nxt.pm * tstep : cA; const char* nB = has_next ? (const char*)g.Bt + (size_t)nxt.pn * tstep : cB;
        for (int t = 0; t < nt; t += 2) {
            const bool last = (t == nt - 2);
            const char* a1 = cA + (size_t)(t + 1) * kstep;
            const char* a2 = last ? nA : cA + (size_t)(t + 2) * kstep; const char* b2 = last ? nB : cB + (size_t)(t + 2) * kstep;
            const char* a3 = a2 + kstep; const char* b3 = b2 + kstep;
            if (last && has_next) S.a_ready(nxt);
            if constexpr (SP2) {
            PG8_LDB(B0, 0, 0); PG8_LDB(B1, 0, 1); PG8_SCHED; PG8_LDA(At, 0, 0); PG8_STAGE(PG8_SA(1, 1), a1 + hstep, voffA);
            PG8_WAIT_V(8); PG8_WAIT_L(0); PG8_BAR; PG8_MMA(0, 0, At, B0); PG8_MMA(0, 1, At, B1); PG8_BAR; PG8_SCHED;
            PG8_LDA(At, 0, 1); PG8_STAGE(PG8_SB(0, 0), b2, voffB); PG8_STAGE(PG8_SB(0, 1), b2 + hstep, voffB); PG8_STAGE(PG8_SA(0, 0), a2, voffA);
            PG8_WAIT_V(8); PG8_WAIT_L(0); PG8_BAR; PG8_MMA(1, 0, At, B0); PG8_MMA(1, 1, At, B1); PG8_BAR; PG8_SCHED;
            PG8_LDB(B0, 1, 0); PG8_LDB(B1, 1, 1); PG8_SCHED; PG8_LDA(At, 1, 0); PG8_STAGE(PG8_SA(0, 1), a2 + hstep, voffA);
            PG8_WAIT_V(8); PG8_WAIT_L(0); PG8_BAR; PG8_MMA(0, 0, At, B0); PG8_MMA(0, 1, At, B1); PG8_BAR; PG8_SCHED;
            PG8_LDA(At, 1, 1); PG8_STAGE(PG8_SB(1, 0), b3, voffB); PG8_STAGE(PG8_SB(1, 1), b3 + hstep, voffB); PG8_STAGE(PG8_SA(1, 0), a3, voffA);
            PG8_WAIT_V(8); PG8_WAIT_L(0); PG8_BAR; PG8_MMA(1, 0, At, B0); PG8_MMA(1, 1, At, B1); PG8_BAR; PG8_SCHED;
            } else {
            PG8_LDB(B0, 0, 0); PG8_SCHED; PG8_LDA(At, 0, 0); PG8_STAGE(PG8_SA(1, 1), a1 + hstep, voffA);
            PG8_WAIT_L(8); PG8_BAR; PG8_WAIT_L(0); PG8_MMA(0, 0, At, B0); PG8_BAR; PG8_SCHED;
            PG8_LDB(B1, 0, 1); PG8_STAGE(PG8_SB(0, 0), b2, voffB);
            PG8_BAR; PG8_WAIT_L(0); PG8_MMA(0, 1, At, B1); PG8_BAR;
            PG8_LDA(At, 0, 1); PG8_STAGE(PG8_SA(0, 0), a2, voffA);
            PG8_BAR; PG8_WAIT_L(0); PG8_MMA(1, 0, At, B0); PG8_BAR; PG8_SCHED;
            PG8_STAGE(PG8_SB(0, 1), b2 + hstep, voffB);
            PG8_WAIT_V(6); PG8_BAR; PG8_MMA(1, 1, At, B1); PG8_BAR;
            PG8_LDB(B0, 1, 0); PG8_SCHED; PG8_LDA(At, 1, 0); PG8_STAGE(PG8_SA(0, 1), a2 + hstep, voffA);
            PG8_WAIT_L(8); PG8_BAR; PG8_WAIT_L(0); PG8_MMA(0, 0, At, B0); PG8_BAR; PG8_SCHED;
            PG8_LDB(B1, 1, 1); PG8_STAGE(PG8_SB(1, 0), b3, voffB);
            PG8_BAR; PG8_WAIT_L(0); PG8_MMA(0, 1, At, B1); PG8_BAR;
            PG8_LDA(At, 1, 1); PG8_STAGE(PG8_SA(1, 0), a3, voffA);
            PG8_BAR; PG8_WAIT_L(0); PG8_MMA(1, 0, At, B0); PG8_BAR; PG8_SCHED;
            PG8_STAGE(PG8_SB(1, 1), b3 + hstep, voffB);
            PG8_WAIT_V(6); PG8_BAR; PG8_MMA(1, 1, At, B1); PG8_BAR;
            }
        }
        if constexpr (ALIGN_EPI) { if (wr == 0) PG8_BAR; }
        if constexpr (!Epi::AFTER_DRAIN) { E(acc, cur, wr, wc, fr, fq); S.done(cur); }
        if (!has_next) break;
#pragma unroll
        for (int a = 0; a < 2; ++a)
#pragma unroll
            for (int b = 0; b < 2; ++b)
#pragma unroll
                for (int m = 0; m < 4; ++m)
#pragma unroll
                    for (int n = 0; n < 2; ++n) acc[a][b][m][n] = (f32x4){0.f, 0.f, 0.f, 0.f};
        cur = nxt; cA = nA; cB = nB; ++ui;
        if constexpr (ALIGN_EPI) { if (wr == 1) PG8_BAR; }
    }
    PG8_WAIT_V(0);
    if constexpr (!ALIGN_EPI) { if (wr == 0) PG8_BAR; }
    PG8_BAR;
    if constexpr (Epi::AFTER_DRAIN) { E.fused(acc, cur, wr, wc, fr, fq, lds, wid, lane); S.done(cur); }
#undef PG8_SA
#undef PG8_SB
#undef PG8_STAGE
#undef PG8_LDA
#undef PG8_LDB
#undef PG8_MMA
#undef PG8_WAIT_V
#undef PG8_WAIT_L
#undef PG8_BAR
#undef PG8_SCHED
}
}
#define LAS __attribute__((address_space(3)))
#define XB_TMO      128
#define XB_XCNT(j)  (256  + 64 * (j))
#define XB_XSUB(j)  (1280 + 64 * (j))
#define XB_XGEN(j)  (2304 + 64 * (j))
#define XB_TOP      3328
#define XB_TOPGEN   3392
#define XCD_BAR_WORDS 3456
#define XB_SPIN_CAP (1u << 18)

__device__ __forceinline__ unsigned xb_ld(unsigned* p)              { return __hip_atomic_load(p, __ATOMIC_RELAXED, __HIP_MEMORY_SCOPE_AGENT); }
__device__ __forceinline__ unsigned xb_add(unsigned* p, unsigned v) { return __hip_atomic_fetch_add(p, v, __ATOMIC_RELAXED, __HIP_MEMORY_SCOPE_AGENT); }
__device__ __forceinline__ unsigned xb_xcc_id() { return (unsigned)__builtin_amdgcn_s_getreg((3 << 11) | 20) & 0xFu; }
#define XB_SPIN(cond, bar) do { unsigned _sp = 0; while (cond) { __builtin_amdgcn_s_sleep(1); \
    if ((++_sp & 255u) == 0u) { if (xb_ld(&(bar)[XB_TMO])) break; if (_sp > XB_SPIN_CAP) { atomicAdd(&(bar)[XB_TMO], 1u); break; } } } } while (0)

struct XcdBarrier {
    unsigned* bar; unsigned x;
    volatile LAS unsigned* st;
};

__device__ __forceinline__ XcdBarrier xcd_barrier_post(unsigned* bar, volatile LAS unsigned* st) {
    XcdBarrier b; b.bar = bar; b.x = xb_xcc_id(); b.st = st;
    if (threadIdx.x == 0) (void)xb_add(&bar[XB_XCNT(b.x)], 1u);
    return b;
}
__device__ __forceinline__ void xcd_barrier_complete(unsigned* bar, unsigned x, unsigned& nloc, unsigned& nx) {
    const unsigned G = gridDim.x * gridDim.y * gridDim.z;
    unsigned sum, cnt, mine, sp = 0u;
    for (;;) {
        sum = 0u; cnt = 0u; mine = 0u;
#pragma unroll
        for (unsigned j = 0; j < 16; ++j) { const unsigned c = xb_ld(&bar[XB_XCNT(j)]); sum += c; cnt += (c > 0u) ? 1u : 0u; mine = (j == x) ? c : mine; }
        if (sum == G) break;
        __builtin_amdgcn_s_sleep(1);
        if ((++sp & 255u) == 0u) { if (xb_ld(&bar[XB_TMO])) break; if (sp > XB_SPIN_CAP) { atomicAdd(&bar[XB_TMO], 1u); break; } }
    }
    nloc = mine > 0u ? mine : 1u; nx = cnt > 0u ? cnt : 1u;
}

__device__ __forceinline__ void xcd_barrier(const XcdBarrier& b) {
    asm volatile("s_waitcnt vmcnt(0)" ::: "memory");
    __syncthreads();
    if (threadIdx.x == 0) {
        unsigned* bar = b.bar;
        __builtin_amdgcn_s_waitcnt(0);
        unsigned nloc = b.st[0], nx = b.st[1];
        if (nloc == 0u) { xcd_barrier_complete(bar, b.x, nloc, nx); b.st[0] = nloc; b.st[1] = nx; }
        const unsigned old = xb_add(&bar[XB_XSUB(b.x)], 1u);
        const unsigned gen = old / nloc;
        if (old + 1u == (gen + 1u) * nloc) {
            __builtin_amdgcn_fence(__ATOMIC_RELEASE, "agent");
            asm volatile("s_waitcnt vmcnt(0)" ::: "memory");
            const unsigned og = xb_add(&bar[XB_TOP], 1u);
            const unsigned tg = og / nx;
            if (og + 1u == (tg + 1u) * nx) xb_add(&bar[XB_TOPGEN], 1u);
            else XB_SPIN(xb_ld(&bar[XB_TOPGEN]) == tg, bar);
            __builtin_amdgcn_fence(__ATOMIC_ACQUIRE, "agent");
            xb_add(&bar[XB_XGEN(b.x)], 1u);
            asm volatile("s_waitcnt vmcnt(0)" ::: "memory");
        } else {
            XB_SPIN(xb_ld(&bar[XB_XGEN(b.x)]) == gen, bar);
            __builtin_amdgcn_fence(__ATOMIC_ACQUIRE, "agent");
            asm volatile("s_waitcnt vmcnt(0)" ::: "memory");
        }
    }
    __syncthreads();
}


using pg8::bf16_t; using pg8::bf16x8; using pg8::f32x4; using pg8::u32x4;

typedef unsigned u32x2 __attribute__((ext_vector_type(2)));

#ifndef ONE_LAUNCH
#define ONE_LAUNCH 1
#endif
constexpr int NPHASE = 10;
#ifndef DEFER_CONV
#define DEFER_CONV 1
#endif
#ifndef REP0
#define REP0 1
#endif
#ifndef REP1
#define REP1 1
#endif
#ifndef REP5
#define REP5 1
#endif
constexpr float EPS = 1e-6f;
constexpr float LOG2E = 1.4426950408889634f;
constexpr int LDS_BYTES = 139264;

constexpr size_t SZ_W13 = (size_t)11264 * 2048 * 2, SZ_W2 = (size_t)2048 * 5632 * 2;
constexpr size_t WS_W13_1 = 0;
constexpr size_t WS_W2_1 = WS_W13_1 + SZ_W13;
constexpr size_t WS_W13_2 = WS_W2_1 + SZ_W2;
constexpr size_t WS_W2_2 = WS_W13_2 + SZ_W13;
constexpr size_t WS_WIN = WS_W2_2 + SZ_W2;
constexpr size_t WS_WOUT = WS_WIN + (size_t)5120 * 2048 * 2;
constexpr size_t WS_WMEM = WS_WOUT + (size_t)2048 * 2048 * 2;
constexpr size_t WS_WFF = WS_WMEM + (size_t)1024 * 2048 * 2;
constexpr size_t WS_RA = WS_WFF + 65536;
constexpr size_t WS_RB = WS_RA + (size_t)16384 * 2048 * 2;
constexpr size_t WS_RH = WS_RB + (size_t)16384 * 2048 * 2;
constexpr size_t WS_MEMB = WS_RH + (size_t)16384 * 5632 * 2;
constexpr size_t WS_MKV = WS_MEMB + (size_t)2048 * 2048 * 2;
constexpr size_t WS_SS1 = WS_MKV + (size_t)2048 * 1024 * 2;
constexpr size_t WS_SS2 = WS_SS1 + 65536;
constexpr size_t WS_SS3 = WS_SS2 + 65536;
constexpr size_t WS_SSM = WS_SS3 + 65536;
constexpr size_t WS_LOGF = WS_SSM + 8192;
constexpr size_t WS_KMEAN = WS_LOGF + 524288;
constexpr size_t WS_CTR = WS_KMEAN + 131072;
constexpr size_t WS_BAR = WS_CTR + 256;
constexpr size_t WS_BND = WS_BAR + 16384;
constexpr size_t WS_END = WS_BND + 256;

struct Params { const float* in[23]; float* out; unsigned char* ws; int ph_lo, ph_hi; };

__device__ __forceinline__ float wave_sum(float v) {
#pragma unroll
    for (int o = 1; o < 64; o <<= 1) v += __shfl_xor(v, o);
    return v;
}
__device__ __forceinline__ unsigned pk2(float a, float b) { return pg8::cvt_pk_bf16(a, b); }
__device__ __forceinline__ float bf_lo(unsigned u) { return __uint_as_float(u << 16); }
__device__ __forceinline__ float bf_hi(unsigned u) { return __uint_as_float(u & 0xffff0000u); }
__device__ __forceinline__ float rstd_of(float ss, float invn) { return 1.0f / sqrtf(ss * invn + EPS); }

struct EpiSwiGLU {
    static constexpr bool PERM = true, AFTER_DRAIN = false;
    bf16_t* H; int ldh; const float* ss;
    __device__ __forceinline__ void operator()(const f32x4 (&acc)[2][2][4][2], const pg8::Unit& u, int wr, int wc, int fr, int fq) const {
        const int row0 = u.pm * 256 + wr * 64 + fr, col0 = u.pn * 128 + wc * 32 + 8 * fq;
#pragma unroll
        for (int ai = 0; ai < 2; ++ai)
#pragma unroll
            for (int m = 0; m < 4; ++m) {
                const int row = row0 + ai * 128 + m * 16;
                const float rs = ss ? rstd_of(ss[row], 1.0f / 2048.0f) : 1.0f;
                u32x4 w;
                unsigned wv[4];
#pragma unroll
                for (int n = 0; n < 2; ++n) {
                    const f32x4 gt = acc[ai][0][m][n] * rs, up = acc[ai][1][m][n] * rs;
                    float hv[4];
#pragma unroll
                    for (int j = 0; j < 4; ++j) { const float e = __builtin_amdgcn_exp2f(-gt[j] * LOG2E); hv[j] = gt[j] * __builtin_amdgcn_rcpf(1.0f + e) * up[j]; }
                    wv[2 * n] = pk2(hv[0], hv[1]); wv[2 * n + 1] = pk2(hv[2], hv[3]);
                }
                w.x = wv[0]; w.y = wv[1]; w.z = wv[2]; w.w = wv[3];
                __builtin_nontemporal_store(w, (u32x4*)(H + (size_t)row * ldh + col0));
            }
    }
};
struct EpiResid {
    static constexpr bool PERM = true, AFTER_DRAIN = false;
    const float* base; float* out; bf16_t* ob; float* ssq; float alpha; int ld;
    __device__ __forceinline__ void operator()(const f32x4 (&acc)[2][2][4][2], const pg8::Unit& u, int wr, int wc, int fr, int fq) const {
        const int row0 = u.pm * 256 + wr * 64 + fr, col0 = u.pn * 256 + wc * 32 + 8 * fq;
#pragma unroll
        for (int ai = 0; ai < 2; ++ai) {
            f32x4 r0[4][2], r1[4][2];
#pragma unroll
            for (int m = 0; m < 4; ++m)
#pragma unroll
                for (int bj = 0; bj < 2; ++bj) { const size_t off = (size_t)(row0 + ai * 128 + m * 16) * ld + col0 + bj * 128;
                    r0[m][bj] = __builtin_nontemporal_load((const f32x4*)(base + off)); r1[m][bj] = __builtin_nontemporal_load((const f32x4*)(base + off + 4)); }
#pragma unroll
            for (int m = 0; m < 4; ++m) {
                const int row = row0 + ai * 128 + m * 16; const size_t off = (size_t)row * ld + col0;
                float s = 0.f;
#pragma unroll
                for (int bj = 0; bj < 2; ++bj) {
                    const f32x4 v0 = r0[m][bj] + acc[ai][bj][m][0] * alpha, v1 = r1[m][bj] + acc[ai][bj][m][1] * alpha;
                    __builtin_nontemporal_store(v0, (f32x4*)(out + off + bj * 128)); __builtin_nontemporal_store(v1, (f32x4*)(out + off + bj * 128 + 4));
                    if (ob) { u32x4 w; w.x = pk2(v0[0], v0[1]); w.y = pk2(v0[2], v0[3]); w.z = pk2(v1[0], v1[1]); w.w = pk2(v1[2], v1[3]); *(u32x4*)(ob + off + bj * 128) = w; }
                    s += (v0[0] * v0[0] + v0[1] * v0[1]) + (v0[2] * v0[2] + v0[3] * v0[3]) + (v1[0] * v1[0] + v1[1] * v1[1]) + (v1[2] * v1[2] + v1[3] * v1[3]);
                }
                if (ssq) { s += __shfl_xor(s, 16); s += __shfl_xor(s, 32); if (fq == 0) atomicAdd(ssq + row, s); }
            }
            asm volatile("" ::: "memory");
        }
    }
};
struct EpiScale {
    static constexpr bool PERM = true, AFTER_DRAIN = false;
    bf16_t* O; int ldc; const float* ss;
    __device__ __forceinline__ void operator()(const f32x4 (&acc)[2][2][4][2], const pg8::Unit& u, int wr, int wc, int fr, int fq) const {
        const int row0 = u.pm * 256 + wr * 64 + fr, col0 = u.pn * 256 + wc * 32 + 8 * fq;
#pragma unroll
        for (int ai = 0; ai < 2; ++ai)
#pragma unroll
            for (int m = 0; m < 4; ++m) {
                const int row = row0 + ai * 128 + m * 16;
                const float rs = rstd_of(ss[row], 1.0f / 2048.0f);
#pragma unroll
                for (int bj = 0; bj < 2; ++bj) {
                    const f32x4 v0 = acc[ai][bj][m][0] * rs, v1 = acc[ai][bj][m][1] * rs;
                    u32x4 w; w.x = pk2(v0[0], v0[1]); w.y = pk2(v0[2], v0[3]); w.z = pk2(v1[0], v1[1]); w.w = pk2(v1[2], v1[3]);
                    *(u32x4*)(O + (size_t)row * ldc + col0 + bj * 128) = w;
                }
            }
    }
};

struct TrItem { const float* W; const float* gain; bf16_t* WT; int ldw, col0, K, drow0, k0; };
__device__ __forceinline__ void tr_decode(const Params& p, int it, TrItem& t) {
    unsigned char* ws = p.ws;
    constexpr int I_W1 = 32 * 88, I_W2 = 88 * 32, I_INA = 32 * 48, I_INB = 32 * 32, I_OUT = 32 * 32;
    int r = it;
    if (r < 4 * I_W1) { const int which = r / I_W1; r -= which * I_W1; const int kb = r / 88, nb = r % 88, n0 = 64 * nb;
        const float *w0 = p.in[3], *w1 = p.in[4], *w2 = p.in[19], *w3 = p.in[20], *ga = p.in[2], *gb = p.in[18];
        asm volatile("" : "+s"(w0), "+s"(w1), "+s"(w2), "+s"(w3), "+s"(ga), "+s"(gb));
        t.W = which == 0 ? w0 : which == 1 ? w1 : which == 2 ? w2 : w3; t.gain = which < 2 ? ga : gb;
        t.WT = (bf16_t*)(ws + (which < 2 ? WS_W13_1 : WS_W13_2)); t.ldw = 5632; t.col0 = n0; t.K = 2048; t.drow0 = 256 * (n0 >> 7) + 128 * (which & 1) + (n0 & 127); t.k0 = 64 * kb; return; }
    r -= 4 * I_W1;
    if (r < 2 * I_W2) { const int which = r / I_W2; r -= which * I_W2; const int kb = r / 32, nb = r % 32;
        const float *w0 = p.in[5], *w1 = p.in[21]; asm volatile("" : "+s"(w0), "+s"(w1));
        t.W = which ? w1 : w0; t.gain = nullptr; t.WT = (bf16_t*)(ws + (which ? WS_W2_2 : WS_W2_1)); t.ldw = 2048; t.col0 = 64 * nb; t.K = 5632; t.drow0 = 64 * nb; t.k0 = 64 * kb; return; }
    r -= 2 * I_W2;
    if (r < I_INA) { const int kb = r / 48, nb = r % 48; t.W = p.in[8]; t.gain = p.in[6]; t.WT = (bf16_t*)(ws + WS_WIN); t.ldw = 5128; t.col0 = 64 * nb; t.K = 2048; t.drow0 = 64 * nb; t.k0 = 64 * kb; return; }
    r -= I_INA;
    if (r < I_INB) { const int kb = r / 32, nb = r % 32; t.W = p.in[8]; t.gain = p.in[6]; t.WT = (bf16_t*)(ws + WS_WIN); t.ldw = 5128; t.col0 = 3080 + 64 * nb; t.K = 2048; t.drow0 = 3072 + 64 * nb; t.k0 = 64 * kb; return; }
    r -= I_INB;
    if (r < I_OUT) { const int kb = r / 32, nb = r % 32; t.W = p.in[17]; t.gain = nullptr; t.WT = (bf16_t*)(ws + WS_WOUT); t.ldw = 2048; t.col0 = 64 * nb; t.K = 2048; t.drow0 = 64 * nb; t.k0 = 64 * kb; return; }
    r -= I_OUT;
    { const int kb = r / 16, nb = r % 16; t.W = p.in[10]; t.gain = p.in[7]; t.WT = (bf16_t*)(ws + WS_WMEM); t.ldw = 1024; t.col0 = 64 * nb; t.K = 2048; t.drow0 = 64 * nb; t.k0 = 64 * kb; }
}
#define TR_LOAD(t) do { const float* _b = (t).W + (size_t)((t).k0 + (lane >> 4)) * (t).ldw + (t).col0 + (lane & 15) * 4; \
        _Pragma("unroll") for (int _i = 0; _i < 16; ++_i) v[_i] = __builtin_nontemporal_load((const f32x4*)(_b + (size_t)(4 * _i) * (t).ldw)); } while (0)
constexpr int TR_N0 = 11520, TR_N1 = 9472;
__device__ __forceinline__ int tr_id(int set, int j) {
    if (set == 0) return j < 5632 ? j : j < 8448 ? 11264 + (j - 5632) : j < 11008 ? 16896 + (j - 8448) : 20480 + (j - 11008);
    return j < 5632 ? 5632 + j : j < 8448 ? 14080 + (j - 5632) : 19456 + (j - 8448);
}
__device__ __forceinline__ void tr_run(const Params& p, LAS float* scr, int lane, int set, int j0, int jend, int stride) {
    f32x4 v[16]; TrItem cur, nxt;
    int it = j0;
    if (it < jend) { tr_decode(p, tr_id(set, it), cur); TR_LOAD(cur); }
    while (it < jend) {
        const int kq = lane >> 4, n4 = (lane & 15) * 4;
#pragma unroll
        for (int i = 0; i < 16; ++i) { const int k = 4 * i + kq;
            scr[(n4 + 0) * 65 + k] = v[i][0]; scr[(n4 + 1) * 65 + k] = v[i][1]; scr[(n4 + 2) * 65 + k] = v[i][2]; scr[(n4 + 3) * 65 + k] = v[i][3]; }
        const int itn = it + stride;
        if (itn < jend) { tr_decode(p, tr_id(set, itn), nxt); TR_LOAD(nxt); }
        asm volatile("s_waitcnt lgkmcnt(0)" ::: "memory");
        const int c = lane & 7;
        f32x4 g0 = {1.f, 1.f, 1.f, 1.f}, g1 = {1.f, 1.f, 1.f, 1.f};
        if (cur.gain) { g0 = *(const f32x4*)(cur.gain + cur.k0 + 8 * c); g1 = *(const f32x4*)(cur.gain + cur.k0 + 8 * c + 4); }
#pragma unroll
        for (int j = 0; j < 8; ++j) { const int n = (lane >> 3) + 8 * j; const LAS float* s = scr + n * 65 + 8 * c;
            u32x4 o; o.x = pk2(s[0] * g0[0], s[1] * g0[1]); o.y = pk2(s[2] * g0[2], s[3] * g0[3]); o.z = pk2(s[4] * g1[0], s[5] * g1[1]); o.w = pk2(s[6] * g1[2], s[7] * g1[3]);
            *(u32x4*)(cur.WT + (size_t)(cur.drow0 + n) * cur.K + cur.k0 + 8 * c) = o; }
        asm volatile("s_waitcnt lgkmcnt(0)" ::: "memory");
        cur = nxt; it = itn;
    }
}
__device__ __forceinline__ void phase0(const Params& p, LAS unsigned char* lds) {
    const int tid = threadIdx.x, lane = tid & 63, wave = __builtin_amdgcn_readfirstlane(tid >> 6);
    const int gw = blockIdx.x * 8 + wave, NGW = gridDim.x * 8;
    LAS float* scr = (LAS float*)(lds + wave * 16640);
    unsigned char* ws = p.ws;
    tr_run(p, scr, lane, DEFER_CONV ? 0 : 0, gw, TR_N0, NGW);
    if (!DEFER_CONV) tr_run(p, scr, lane, 1, gw, TR_N1, NGW);
    for (int m2 = gw; m2 < (16384 + 2048) / 2; m2 += NGW) {
        const int m = 2 * m2; const bool ismem = m >= 16384; const int r = ismem ? m - 16384 : m;
        const float *px = p.in[0], *pm = p.in[1]; asm volatile("" : "+s"(px), "+s"(pm));
        const f32x4* src = (const f32x4*)((ismem ? pm : px) + (size_t)r * 2048);
        u32x2* dst = (u32x2*)((bf16_t*)(ws + (ismem ? WS_MEMB : WS_RA)) + (size_t)r * 2048);
        f32x4 a[8], bq[8];
#pragma unroll
        for (int j = 0; j < 8; ++j) { a[j] = __builtin_nontemporal_load(src + lane + 64 * j); bq[j] = __builtin_nontemporal_load(src + 512 + lane + 64 * j); }
        float s0 = 0.f, s1 = 0.f;
#pragma unroll
        for (int j = 0; j < 8; ++j) { const f32x4 x = a[j], y = bq[j];
            s0 += (x[0] * x[0] + x[1] * x[1]) + (x[2] * x[2] + x[3] * x[3]); s1 += (y[0] * y[0] + y[1] * y[1]) + (y[2] * y[2] + y[3] * y[3]); }
        s0 = wave_sum(s0); s1 = wave_sum(s1);
        const float r0 = ismem ? 1.0f : rstd_of(s0, 1.0f / 2048.0f), r1 = ismem ? 1.0f : rstd_of(s1, 1.0f / 2048.0f);
#pragma unroll
        for (int j = 0; j < 8; ++j) { const f32x4 x = a[j] * r0, y = bq[j] * r1;
            u32x2 o; o.x = pk2(x[0], x[1]); o.y = pk2(x[2], x[3]); dst[lane + 64 * j] = o;
            u32x2 q; q.x = pk2(y[0], y[1]); q.y = pk2(y[2], y[3]); dst[512 + lane + 64 * j] = q; }
        if (lane == 0 && ismem) { float* so = (float*)(ws + WS_SSM); so[r] = s0; so[r + 1] = s1; }
    }
    const int gt = blockIdx.x * 512 + tid, NGT = gridDim.x * 512;
    for (int i = gt; i < 16384; i += NGT) { ((float*)(ws + WS_SS2))[i] = 0.f; ((float*)(ws + WS_SS3))[i] = 0.f;
        const int h = i >> 11, k = i & 2047; ((float*)(ws + WS_WFF))[i] = p.in[6][k] * p.in[8][(size_t)k * 5128 + 3072 + h]; }
    for (int i = gt; i < 32768; i += NGT) ((float*)(ws + WS_KMEAN))[i] = 0.f;
    if (gt < 8) ((unsigned*)(ws + WS_CTR))[gt] = 0u;
    if (blockIdx.x == 0 && wave < 3) {
        const float* gq = wave == 0 ? p.in[11] : wave == 1 ? p.in[13] : p.in[15]; const float* gk = wave == 0 ? p.in[12] : wave == 1 ? p.in[14] : p.in[16];
        float mq = fmaxf(fabsf(gq[lane]), fabsf(gq[lane + 64])), mk = fmaxf(fabsf(gk[lane]), fabsf(gk[lane + 64])), mb = fmaxf(fabsf(p.in[22][lane]), fabsf(p.in[22][lane + 64]));
#pragma unroll
        for (int o = 1; o < 64; o <<= 1) { mq = fmaxf(mq, __shfl_xor(mq, o)); mk = fmaxf(mk, __shfl_xor(mk, o)); mb = fmaxf(mb, __shfl_xor(mb, o)); }
        if (lane == 0) ((float*)(ws + WS_BND))[wave] = 128.0f * 0.08838834764831845f * LOG2E * mq * mk * 1.02f + (wave == 1 ? mb * LOG2E : 0.f);
    }
}

struct F8 { f32x4 a, b; };
__device__ __forceinline__ F8 headnorm_r(const u32x4 raw, const f32x4 g0, const f32x4 g1, u32x4& packed) {
    f32x4 a = {bf_lo(raw.x), bf_hi(raw.x), bf_lo(raw.y), bf_hi(raw.y)}, b = {bf_lo(raw.z), bf_hi(raw.z), bf_lo(raw.w), bf_hi(raw.w)};
    float s = (a[0] * a[0] + a[1] * a[1]) + (a[2] * a[2] + a[3] * a[3]) + (b[0] * b[0] + b[1] * b[1]) + (b[2] * b[2] + b[3] * b[3]);
    s += __shfl_xor(s, 1); s += __shfl_xor(s, 2); s += __shfl_xor(s, 4); s += __shfl_xor(s, 8);
    const float r = rstd_of(s, 1.0f / 128.0f);
    a = a * r * g0; b = b * r * g1;
    packed.x = pk2(a[0], a[1]); packed.y = pk2(a[2], a[3]); packed.z = pk2(b[0], b[1]); packed.w = pk2(b[2], b[3]);
    F8 res; res.a = a; res.b = b; return res;
}
__device__ __forceinline__ void vt_tile(bf16_t* base, int pitch, LAS unsigned short* T, int lane) {
    u32x4 v[16];
#pragma unroll
    for (int i = 0; i < 16; ++i) { const int c = lane + 64 * i, r = c >> 4, cc = c & 15; v[i] = *(const u32x4*)(base + (size_t)r * pitch + cc * 8); }
#pragma unroll
    for (int i = 0; i < 16; ++i) { const int c = lane + 64 * i, r = c >> 4, cc = c & 15;
        LAS unsigned* w = (LAS unsigned*)(T + r * 130 + cc * 8);
        w[0] = v[i].x; w[1] = v[i].y; w[2] = v[i].z; w[3] = v[i].w; }
    asm volatile("s_waitcnt lgkmcnt(0)" ::: "memory");
#pragma unroll
    for (int i = 0; i < 16; ++i) { const int c = lane + 64 * i, r = c >> 4, cc = c & 15, d = 2 * r + (cc >> 3), k0 = 8 * (cc & 7);
        const int kc = k0 >> 3, kbase = 32 * (kc >> 2) + 4 * (kc & 3);
        const LAS unsigned short* s = T + kbase * 130 + d;
        u32x4 o;
        o.x = (unsigned)s[0 * 130] | ((unsigned)s[1 * 130] << 16); o.y = (unsigned)s[2 * 130] | ((unsigned)s[3 * 130] << 16);
        o.z = (unsigned)s[16 * 130] | ((unsigned)s[17 * 130] << 16); o.w = (unsigned)s[18 * 130] | ((unsigned)s[19 * 130] << 16);
        *(u32x4*)(base + (size_t)r * pitch + cc * 8) = o; }
    asm volatile("s_waitcnt lgkmcnt(0)" ::: "memory");
}
struct PostRow { u32x4 c0, c1, c2, c3, c6, c7, c9; u32x2 x[8]; };
#define POST_LOAD(R, row) do { const bf16_t* _P = proj + (size_t)(row) * 5120 + lane * 8; const bf16_t* _X = x1b + (size_t)(row) * 2048 + lane * 4; \
        R.c0 = *(const u32x4*)(_P); R.c1 = *(const u32x4*)(_P + 512); R.c2 = *(const u32x4*)(_P + 1024); R.c3 = *(const u32x4*)(_P + 1536); \
        R.c6 = *(const u32x4*)(_P + 3072); R.c7 = *(const u32x4*)(_P + 3584); R.c9 = *(const u32x4*)(_P + 4608); \
        _Pragma("unroll") for (int _j = 0; _j < 8; ++_j) R.x[_j] = __builtin_nontemporal_load((const u32x2*)(_X + 256 * _j)); } while (0)
__device__ __forceinline__ void post_phase(const Params& p, LAS unsigned char* lds, int rb, int nb, bool do_ab, bool do_c) {
    const int tid = threadIdx.x, lane = tid & 63, wave = __builtin_amdgcn_readfirstlane(tid >> 6);
    const int gw = blockIdx.x * 8 + wave, NGW = gridDim.x * 8;
    const int w = rb * 8 + wave, W = nb * 8;
    unsigned char* ws = p.ws;
    bf16_t* proj = (bf16_t*)(ws + WS_RH); bf16_t* mkv = (bf16_t*)(ws + WS_MKV);
    const bf16_t* x1b = (const bf16_t*)(ws + WS_RA);
    const float* ss2 = (const float*)(ws + WS_SS2); const float* wff = (const float*)(ws + WS_WFF);
    float* logf_ = (float*)(ws + WS_LOGF); float* kmean = (float*)(ws + WS_KMEAN);
    LAS float* wl = (LAS float*)lds;
    if (do_ab) {
#pragma unroll
    for (int i = 0; i < 8; ++i) *(LAS f32x4*)(wl + (tid + 512 * i) * 4) = *(const f32x4*)(wff + (tid + 512 * i) * 4);
    }
    __syncthreads();
    const int go = (lane & 15) * 8;
    const float QSC = 0.08838834764831845f * LOG2E;
    const f32x4 gfq0 = *(const f32x4*)(p.in[11] + go) * QSC, gfq1 = *(const f32x4*)(p.in[11] + go + 4) * QSC, gfk0 = *(const f32x4*)(p.in[12] + go), gfk1 = *(const f32x4*)(p.in[12] + go + 4);
    const f32x4 gbq0 = *(const f32x4*)(p.in[13] + go) * QSC, gbq1 = *(const f32x4*)(p.in[13] + go + 4) * QSC, gbk0 = *(const f32x4*)(p.in[14] + go), gbk1 = *(const f32x4*)(p.in[14] + go + 4);
    const f32x4 gcq0 = *(const f32x4*)(p.in[15] + go) * QSC, gcq1 = *(const f32x4*)(p.in[15] + go + 4) * QSC;
    if (do_ab) {
        const int r0 = (int)(((long long)w * 16384) / W), r1 = (int)(((long long)(w + 1) * 16384) / W);
        f32x4 ka = {0.f, 0.f, 0.f, 0.f}, kb = {0.f, 0.f, 0.f, 0.f};
        PostRow cur, nxt;
        if (r0 < r1) POST_LOAD(cur, r0);
        for (int row = r0; row < r1; ++row) {
            if (row + 1 < r1) POST_LOAD(nxt, row + 1);
            bf16_t* P = proj + (size_t)row * 5120 + lane * 8;
            u32x4 o;
            headnorm_r(cur.c0, gfq0, gfq1, o); *(u32x4*)(P) = o;
            headnorm_r(cur.c1, gfq0, gfq1, o); *(u32x4*)(P + 512) = o;
            headnorm_r(cur.c2, gfk0, gfk1, o); *(u32x4*)(P + 1024) = o;
            headnorm_r(cur.c3, gfk0, gfk1, o); *(u32x4*)(P + 1536) = o;
            headnorm_r(cur.c6, gbq0, gbq1, o); *(u32x4*)(P + 3072) = o;
            { const F8 kk = headnorm_r(cur.c7, gbk0, gbk1, o); *(u32x4*)(P + 3584) = o; ka += kk.a; kb += kk.b; }
            headnorm_r(cur.c9, gcq0, gcq1, o); *(u32x4*)(P + 4608) = o;
            float d0 = 0.f, d1 = 0.f, d2 = 0.f, d3 = 0.f, d4 = 0.f, d5 = 0.f, d6 = 0.f, d7 = 0.f;
#pragma unroll
            for (int j = 0; j < 8; ++j) {
                const f32x4 xa = {bf_lo(cur.x[j].x), bf_hi(cur.x[j].x), bf_lo(cur.x[j].y), bf_hi(cur.x[j].y)};
                const LAS float* wp = wl + 256 * j + 4 * lane;
#define FF_DOT(H, D) { const f32x4 w0 = *(const LAS f32x4*)(wp + (H) * 2048); D += (xa[0] * w0[0] + xa[1] * w0[1]) + (xa[2] * w0[2] + xa[3] * w0[3]); }
                FF_DOT(0, d0) FF_DOT(1, d1) FF_DOT(2, d2) FF_DOT(3, d3) FF_DOT(4, d4) FF_DOT(5, d5) FF_DOT(6, d6) FF_DOT(7, d7)
#undef FF_DOT
            }
            d0 = wave_sum(d0); d1 = wave_sum(d1); d2 = wave_sum(d2); d3 = wave_sum(d3); d4 = wave_sum(d4); d5 = wave_sum(d5); d6 = wave_sum(d6); d7 = wave_sum(d7);
            if (lane < 8) {
                const float dv = lane == 0 ? d0 : lane == 1 ? d1 : lane == 2 ? d2 : lane == 3 ? d3 : lane == 4 ? d4 : lane == 5 ? d5 : lane == 6 ? d6 : d7;
                const float z = dv * rstd_of(ss2[row], 1.0f / 2048.0f) + p.in[9][lane];
                logf_[(size_t)row * 8 + lane] = fminf(z, 0.f) - log1pf(__expf(-fabsf(z)));
            }
            cur = nxt;
            if ((row & 255) == 255 || row + 1 == r1) {
                const int b = row >> 11, blk = (row & 2047) >> 8, h = lane >> 4;
                float* km = kmean + ((size_t)((b * 4 + h) * 8 + blk)) * 128 + (lane & 15) * 8;
                const float sc = 1.0f / 256.0f;
                atomicAdd(km + 0, ka[0] * sc); atomicAdd(km + 1, ka[1] * sc); atomicAdd(km + 2, ka[2] * sc); atomicAdd(km + 3, ka[3] * sc);
                atomicAdd(km + 4, kb[0] * sc); atomicAdd(km + 5, kb[1] * sc); atomicAdd(km + 6, kb[2] * sc); atomicAdd(km + 7, kb[3] * sc);
                ka = (f32x4){0.f, 0.f, 0.f, 0.f}; kb = (f32x4){0.f, 0.f, 0.f, 0.f};
            }
        }
    }
    if (do_c) { const f32x4 g0 = *(const f32x4*)(p.in[16] + go), g1 = *(const f32x4*)(p.in[16] + go + 4);
      for (int row = gw; row < 2048; row += NGW) { bf16_t* P = mkv + (size_t)row * 1024 + lane * 8; u32x4 o; headnorm_r(*(const u32x4*)P, g0, g1, o); *(u32x4*)P = o; } }
    __syncthreads();
    LAS unsigned short* T = (LAS unsigned short*)(lds + wave * 16640);
    for (int it = do_ab ? w : 3072 + gw; it < (do_ab ? 3072 : 3072 + 128); it += (do_ab ? W : NGW)) {
        bf16_t* base; int pitch;
        if (it < 3072) { const int tile = it / 12, hs = it % 12; const int col = hs < 8 ? 2048 + 128 * hs : 4096 + 128 * (hs - 8); base = proj + (size_t)(64 * tile) * 5120 + col; pitch = 5120; }
        else { const int r = it - 3072, tile = r >> 2, h = r & 3; base = mkv + (size_t)(64 * tile) * 1024 + 512 + 128 * h; pitch = 1024; }
        vt_tile(base, pitch, T, lane);
    }
    __syncthreads();
}
#undef POST_LOAD
__device__ __forceinline__ void mem_own_post(const Params& p, LAS unsigned char* lds, int pm, int pn) {
    const int tid = threadIdx.x, lane = tid & 63, wave = __builtin_amdgcn_readfirstlane(tid >> 6);
    bf16_t* mkv = (bf16_t*)(p.ws + WS_MKV);
    __builtin_amdgcn_fence(__ATOMIC_ACQUIRE, "agent");
    asm volatile("s_waitcnt vmcnt(0)" ::: "memory");
    __syncthreads();
    if (pn < 2) {
        const int go = (lane & 15) * 8;
        const f32x4 g0 = *(const f32x4*)(p.in[16] + go), g1 = *(const f32x4*)(p.in[16] + go + 4);
#pragma unroll 4
        for (int i = 0; i < 16; ++i) { bf16_t* P = mkv + (size_t)(256 * pm + 32 * wave + 2 * i + (lane >> 5)) * 1024 + 256 * pn + (lane & 31) * 8;
            u32x4 o; headnorm_r(*(const u32x4*)P, g0, g1, o); *(u32x4*)P = o; }
    } else {
        const int tile = 4 * pm + (wave >> 1), h = 2 * (pn - 2) + (wave & 1);
        vt_tile(mkv + (size_t)(64 * tile) * 1024 + 512 + 128 * h, 1024, (LAS unsigned short*)(lds + wave * 16640), lane);
    }
}


__device__ __forceinline__ void attn_phase(const Params& p, LAS unsigned char* lds, int rep) {
    const int wave = __builtin_amdgcn_readfirstlane(threadIdx.x >> 6);
    unsigned char* ws = p.ws;
    const bf16_t* proj = (const bf16_t*)(ws + WS_RH); const bf16_t* mkv = (const bf16_t*)(ws + WS_MKV);
    bf16_t* obuf = (bf16_t*)(ws + WS_RA);
    const float* logf_ = (const float*)(ws + WS_LOGF); const float* kmean = (const float*)(ws + WS_KMEAN);
    unsigned* ctr = (unsigned*)(ws + WS_CTR) + rep;
    LAS unsigned char* Kb = lds; LAS unsigned char* Vb = lds + 32768;
    LAS float* cs = (LAS float*)(lds + 69632); LAS float* tab = (LAS float*)(lds + 77824);
    LAS unsigned* selm = (LAS unsigned*)(lds + 78336); LAS int* misc = (LAS int*)(lds + 133632); LAS float* wtot = (LAS float*)(lds + 133632 + 64);
    const float NINF = -__builtin_inff();
    for (;;) {
        int tid = threadIdx.x; asm volatile("" : "+v"(tid));
        int lane = tid & 63;
        __syncthreads();
        if (tid == 0) misc[0] = (int)atomicAdd(ctr, 1u);
        __syncthreads();
        const int qi = __builtin_amdgcn_readfirstlane(misc[0]);
        int idx;
        if (DEFER_CONV) {
            if (qi >= 1024 + 592) break;
            if (qi < 256) idx = qi;
            else if (qi < 256 + 1184) { const int q2 = qi - 256;
                if (q2 & 1) { const int cblk = q2 >> 1; tr_run(p, (LAS float*)(lds + wave * 16640), lane, 1, 16 * cblk + 2 * wave, 16 * cblk + 2 * wave + 2, 1); continue; }
                idx = 256 + (q2 >> 1);
            } else idx = 848 + (qi - 1440);
        } else { idx = qi; if (idx >= 1024) break; }
        int type, b, h, qb;
        if (idx < 768) { const int lvl = idx / 96, r = idx % 96; qb = 7 - lvl; if (r < 64) { type = 0; b = r >> 3; h = r & 7; } else { type = 1; b = (r - 64) >> 2; h = (r - 64) & 3; } }
        else { const int r = idx - 768; type = 2; b = r >> 5; h = (r >> 3) & 3; qb = r & 7; }
        const bf16_t *Qp, *Kp, *Vp; int kpitch, nt, hg; size_t krow0;
        if (type == 0) { Qp = proj + 128 * h; Kp = proj + 1024 + 128 * h; Vp = proj + 2048 + 128 * h; kpitch = 5120; nt = 4 * (qb + 1); hg = h; krow0 = (size_t)b * 2048; }
        else if (type == 1) { Qp = proj + 3072 + 128 * h; Kp = proj + 3584 + 128 * h; Vp = proj + 4096 + 128 * h; kpitch = 5120; nt = 4 * (qb + 1); hg = 8 + h; krow0 = (size_t)b * 2048; }
        else { Qp = proj + 4608 + 128 * h; Kp = mkv + 128 * h; Vp = mkv + 512 + 128 * h; kpitch = 1024; nt = 4; hg = 12 + h; krow0 = (size_t)b * 256; }
        const int qrow0 = qb * 256 + wave * 32;
        const float Bt = ((const float*)(ws + WS_BND))[type];
        if (type == 0) {
            const float* lf = logf_ + (size_t)(b * 2048) * 8 + h;
            const float v0 = lf[(4 * tid + 0) * 8], v1 = lf[(4 * tid + 1) * 8], v2 = lf[(4 * tid + 2) * 8], v3 = lf[(4 * tid + 3) * 8];
            const float s1 = v0, s2 = s1 + v1, s3 = s2 + v2, s4 = s3 + v3;
            float tot = s4;
#pragma unroll
            for (int o = 1; o < 64; o <<= 1) { const float n = __shfl_up(tot, o); if (lane >= o) tot += n; }
            if (lane == 63) wtot[wave] = tot;
            __syncthreads();
            float basev = 0.f;
            for (int w = 0; w < wave; ++w) basev += wtot[w];
            const float excl = basev + tot - s4;
            cs[4 * tid + 0] = (excl + s1) * LOG2E; cs[4 * tid + 1] = (excl + s2) * LOG2E; cs[4 * tid + 2] = (excl + s3) * LOG2E; cs[4 * tid + 3] = (excl + s4) * LOG2E;
            __syncthreads();
        } else if (type == 1) {
            if (tid < 128) { const int n = tid; int bk = n; if (n >= 16) { bk = 16 + (int)(__logf((float)n * (1.0f / 16.0f)) / 2.0794415416798357f * 16.0f); bk = bk > 31 ? 31 : bk; }
                tab[tid] = p.in[22][bk * 4 + h] * LOG2E - Bt; }
            { const int q = tid >> 1, half = tid & 1; const bf16_t* qr = Qp + (size_t)(b * 2048 + qb * 256 + q) * 5120 + 64 * half;
              for (int j = 0; j < qb; ++j) {
                  const float* km = kmean + ((size_t)((b * 4 + h) * 8 + j)) * 128 + 64 * half; float a = 0.f;
#pragma unroll
                  for (int c8 = 0; c8 < 8; ++c8) { const u32x4 raw = *(const u32x4*)(qr + 8 * c8); const f32x4 k0 = *(const f32x4*)(km + 8 * c8), k1 = *(const f32x4*)(km + 8 * c8 + 4);
                      a += (bf_lo(raw.x) * k0[0] + bf_hi(raw.x) * k0[1]) + (bf_lo(raw.y) * k0[2] + bf_hi(raw.y) * k0[3]) + (bf_lo(raw.z) * k1[0] + bf_hi(raw.z) * k1[1]) + (bf_lo(raw.w) * k1[2] + bf_hi(raw.w) * k1[3]); }
                  a += __shfl_xor(a, 1);
                  if (half == 0) cs[q * 8 + j] = a;
              } }
            __syncthreads();
            if (tid < 256) { unsigned mask = 0u;
                for (int j = 0; j < qb; ++j) { const float gj = cs[tid * 8 + j]; int rank = 0;
                    for (int i = 0; i < qb; ++i) { const float gi = cs[tid * 8 + i]; rank += (gi > gj || (gi == gj && i < j)) ? 1 : 0; }
                    if (rank < 3) mask |= 1u << j; }
                selm[tid] = mask; }
            __syncthreads();
        }
        tid = threadIdx.x; asm volatile("" : "+v"(tid));
        lane = tid & 63;
        const int fr = lane & 15, g = lane >> 4;
        bf16x8 Qf[2][4];
#pragma unroll
        for (int sub = 0; sub < 2; ++sub)
#pragma unroll
            for (int ks = 0; ks < 4; ++ks) Qf[sub][ks] = *(const bf16x8*)(Qp + (size_t)(b * 2048 + qrow0 + 16 * sub + fr) * 5120 + 32 * ks + 8 * g);
        float cq0 = 0.f, cq1 = 0.f; unsigned sm0 = 0u, sm1 = 0u; float tab127 = 0.f;
        if (type == 0) { cq0 = cs[qrow0 + fr] - Bt; cq1 = cs[qrow0 + 16 + fr] - Bt; }
        if (type == 1) { sm0 = selm[wave * 32 + fr]; sm1 = selm[wave * 32 + 16 + fr]; tab127 = tab[127]; }
        f32x4 O[2][8];
#pragma unroll
        for (int sub = 0; sub < 2; ++sub)
#pragma unroll
            for (int db = 0; db < 8; ++db) O[sub][db] = (f32x4){0.f, 0.f, 0.f, 0.f};
        float l0 = 0.f, l1 = 0.f;
        const int sr0 = tid >> 4, scc = tid & 15;
        const unsigned kdst0 = (unsigned)(sr0 * 256 + ((scc ^ (sr0 & 15)) << 4)), kdst1 = kdst0 + 32 * 256;
        const unsigned vdst0 = (unsigned)((2 * sr0 + (scc >> 3)) * 128 + (((scc & 7) ^ (sr0 & 7)) << 4)), vdst1 = vdst0 + 64 * 128;
        u32x4 kr0, kr1, vr0, vr1;
#define ATT_LOAD(kt) do { const size_t rb = krow0 + (size_t)64 * (kt) + sr0; \
            kr0 = *(const u32x4*)(Kp + rb * kpitch + scc * 8); kr1 = *(const u32x4*)(Kp + (rb + 32) * kpitch + scc * 8); \
            vr0 = *(const u32x4*)(Vp + rb * kpitch + scc * 8); vr1 = *(const u32x4*)(Vp + (rb + 32) * kpitch + scc * 8); } while (0)
#define ATT_STORE(buf) do { *(LAS u32x4*)(Kb + (buf) * 16384 + kdst0) = kr0; *(LAS u32x4*)(Kb + (buf) * 16384 + kdst1) = kr1; \
            *(LAS u32x4*)(Vb + (buf) * 16384 + vdst0) = vr0; *(LAS u32x4*)(Vb + (buf) * 16384 + vdst1) = vr1; } while (0)
        ATT_LOAD(0); ATT_STORE(0);
        __syncthreads();
        for (int kt = 0; kt < nt; ++kt) {
            const bool more = kt + 1 < nt;
            if (more) ATT_LOAD(kt + 1);
            const int k0 = 64 * kt;
            const bool active = (type == 2) || (k0 <= qrow0 + 31);
            if (active) {
                const LAS unsigned char* Kc = Kb + (kt & 1) * 16384; const LAS unsigned char* Vc = Vb + (kt & 1) * 16384;
                f32x4 S[4][2];
                const bool diag = (k0 + 63 > qrow0);
                const int blk = k0 >> 8; const bool ownblk = (blk == qb);
                if (type == 0) {
#pragma unroll
                    for (int kb = 0; kb < 4; ++kb) { const f32x4 ck = *(const LAS f32x4*)(cs + k0 + 16 * kb + 4 * g);
                        S[kb][0] = cq0 - ck; S[kb][1] = cq1 - ck; }
                } else if (type == 1) {
                    const bool nearb = (qrow0 - (k0 + 63) < 127);
                    if (nearb) {
#pragma unroll
                        for (int kb = 0; kb < 4; ++kb)
#pragma unroll
                            for (int sub = 0; sub < 2; ++sub)
#pragma unroll
                                for (int i = 0; i < 4; ++i) { int di = (qrow0 + 16 * sub + fr) - (k0 + 16 * kb + 4 * g + i); di = di < 0 ? 0 : di; di = di > 127 ? 127 : di; S[kb][sub][i] = tab[di]; }
                    } else {
#pragma unroll
                        for (int kb = 0; kb < 4; ++kb) { S[kb][0] = (f32x4){tab127, tab127, tab127, tab127}; S[kb][1] = S[kb][0]; }
                    }
                } else {
#pragma unroll
                    for (int kb = 0; kb < 4; ++kb) { S[kb][0] = (f32x4){-Bt, -Bt, -Bt, -Bt}; S[kb][1] = S[kb][0]; }
                }
                {
#define ATT_LDK(dst, kb) do { _Pragma("unroll") for (int _ks = 0; _ks < 4; ++_ks) dst[_ks] = *(const LAS bf16x8*)(Kc + (16 * (kb) + fr) * 256 + (((4 * _ks + g) ^ fr) << 4)); } while (0)
#define ATT_QK(src, kb) do { _Pragma("unroll") for (int _ks = 0; _ks < 4; ++_ks) { \
                        S[kb][0] = __builtin_amdgcn_mfma_f32_16x16x32_bf16(src[_ks], Qf[0][_ks], S[kb][0], 0, 0, 0); \
                        S[kb][1] = __builtin_amdgcn_mfma_f32_16x16x32_bf16(src[_ks], Qf[1][_ks], S[kb][1], 0, 0, 0); } } while (0)
                    bf16x8 kfa[4], kfb[4];
                    ATT_LDK(kfa, 0); ATT_LDK(kfb, 1);
                    __builtin_amdgcn_sched_barrier(0);
                    ATT_QK(kfa, 0);
                    __builtin_amdgcn_sched_barrier(0);
                    ATT_LDK(kfa, 2);
                    __builtin_amdgcn_sched_barrier(0);
                    ATT_QK(kfb, 1);
                    __builtin_amdgcn_sched_barrier(0);
                    ATT_LDK(kfb, 3);
                    __builtin_amdgcn_sched_barrier(0);
                    ATT_QK(kfa, 2);
                    __builtin_amdgcn_sched_barrier(0);
                    ATT_QK(kfb, 3);
                    __builtin_amdgcn_sched_barrier(0);
#undef ATT_LDK
#undef ATT_QK
                }
                if (type != 2 && ownblk && diag) {
#pragma unroll
                    for (int kb = 0; kb < 4; ++kb)
#pragma unroll
                        for (int sub = 0; sub < 2; ++sub)
#pragma unroll
                            for (int i = 0; i < 4; ++i) if (k0 + 16 * kb + 4 * g + i > qrow0 + 16 * sub + fr) S[kb][sub][i] = NINF;
                }
                if (type == 1 && !ownblk) {
                    const bool ok0 = ((sm0 >> blk) & 1u) != 0u, ok1 = ((sm1 >> blk) & 1u) != 0u;
#pragma unroll
                    for (int kb = 0; kb < 4; ++kb) { if (!ok0) S[kb][0] = (f32x4){NINF, NINF, NINF, NINF}; if (!ok1) S[kb][1] = (f32x4){NINF, NINF, NINF, NINF}; }
                }
                __builtin_amdgcn_sched_barrier(0);
                {
                    float rs0 = 0.f, rs1 = 0.f;
#pragma unroll
                    for (int kb = 0; kb < 4; ++kb)
#pragma unroll
                        for (int i = 0; i < 4; ++i) { const float p0 = __builtin_amdgcn_exp2f(S[kb][0][i]), p1 = __builtin_amdgcn_exp2f(S[kb][1][i]);
                            S[kb][0][i] = p0; S[kb][1][i] = p1; rs0 += p0; rs1 += p1; }
                    l0 += rs0; l1 += rs1;
                }
                {
                    bf16x8 Pf[2][2];
#pragma unroll
                    for (int kk = 0; kk < 2; ++kk)
#pragma unroll
                        for (int sub = 0; sub < 2; ++sub) { u32x4 w; w.x = pk2(S[2 * kk][sub][0], S[2 * kk][sub][1]); w.y = pk2(S[2 * kk][sub][2], S[2 * kk][sub][3]);
                            w.z = pk2(S[2 * kk + 1][sub][0], S[2 * kk + 1][sub][1]); w.w = pk2(S[2 * kk + 1][sub][2], S[2 * kk + 1][sub][3]); Pf[kk][sub] = __builtin_bit_cast(bf16x8, w); }
#define ATT_LDV(dst, dg) do { _Pragma("unroll") for (int _d = 0; _d < 2; ++_d) _Pragma("unroll") for (int _kk = 0; _kk < 2; ++_kk) \
                        dst[_d][_kk] = *(const LAS bf16x8*)(Vc + (16 * (2 * (dg) + _d) + fr) * 128 + (((4 * _kk + g) ^ (fr >> 1)) << 4)); } while (0)
#define ATT_PV(src, dg) do { _Pragma("unroll") for (int _d = 0; _d < 2; ++_d) _Pragma("unroll") for (int _kk = 0; _kk < 2; ++_kk) { \
                        O[0][2 * (dg) + _d] = __builtin_amdgcn_mfma_f32_16x16x32_bf16(src[_d][_kk], Pf[_kk][0], O[0][2 * (dg) + _d], 0, 0, 0); \
                        O[1][2 * (dg) + _d] = __builtin_amdgcn_mfma_f32_16x16x32_bf16(src[_d][_kk], Pf[_kk][1], O[1][2 * (dg) + _d], 0, 0, 0); } } while (0)
                    bf16x8 va[2][2], vb[2][2], vc[2][2];
                    ATT_LDV(va, 0); ATT_LDV(vb, 1);
                    __builtin_amdgcn_sched_barrier(0);
                    ATT_LDV(vc, 2);
                    ATT_PV(va, 0);
                    __builtin_amdgcn_sched_barrier(0);
                    ATT_LDV(va, 3);
                    ATT_PV(vb, 1);
                    __builtin_amdgcn_sched_barrier(0);
                    ATT_PV(vc, 2);
                    __builtin_amdgcn_sched_barrier(0);
                    ATT_PV(va, 3);
                    __builtin_amdgcn_sched_barrier(0);
#undef ATT_LDV
#undef ATT_PV
                }
            }
            if (more) ATT_STORE((kt + 1) & 1);
            __syncthreads();
        }
#undef ATT_LOAD
#undef ATT_STORE
#pragma unroll
        for (int sub = 0; sub < 2; ++sub) {
            float l = sub ? l1 : l0; l += __shfl_xor(l, 16); l += __shfl_xor(l, 32);
            const float inv = 1.0f / l;
            bf16_t* orow = obuf + (size_t)(b * 2048 + qrow0 + 16 * sub + fr) * 2048 + hg * 128 + 4 * g;
#pragma unroll
            for (int db = 0; db < 8; ++db) { const f32x4 v = O[sub][db] * inv; u32x2 w; w.x = pk2(v[0], v[1]); w.y = pk2(v[2], v[3]); *(u32x2*)(orow + 16 * db) = w; }
        }
    }
}

__global__ void __launch_bounds__(512, 2) fwd_mega(Params p) {
    extern __shared__ __attribute__((aligned(16))) unsigned char lds_raw[];
    LAS unsigned char* lds = (LAS unsigned char*)lds_raw;
    cg::grid_group grid = cg::this_grid();
    unsigned char* ws = p.ws;
    const int lo = p.ph_lo, hi = p.ph_hi, G = gridDim.x, c = blockIdx.x;
#define IN(k) (lo <= (k) && (k) < hi)
#define SEAM(k) do { if (IN(k) && IN((k) + 1)) xcd_barrier(xbar); } while (0)
    bf16_t* RA = (bf16_t*)(ws + WS_RA); bf16_t* RB = (bf16_t*)(ws + WS_RB); bf16_t* RH = (bf16_t*)(ws + WS_RH);
    volatile LAS unsigned* xst = (volatile LAS unsigned*)(lds + LDS_BYTES - 64);
    if (threadIdx.x < 4) xst[threadIdx.x] = 0u;
    __syncthreads();
    XcdBarrier xbar; xbar.bar = (unsigned*)(ws + WS_BAR); xbar.x = 0; xbar.st = xst;
    if (hi - lo > 1) xbar = xcd_barrier_post((unsigned*)(ws + WS_BAR), xst);
    if (lo < 0) grid.sync();
    if (IN(0)) { for (int rep = 0; rep < REP0; ++rep) { phase0(p, lds); __syncthreads(); } }
    SEAM(0);
    if (IN(1)) {
        pg8::Gemm gm{RA, (const bf16_t*)(ws + WS_W13_1), 16384, 11264, 2048}; pg8::StaticOrder S; S.init(16384, 11264, G, c);
        EpiSwiGLU E{RH, 5632, nullptr};
        for (int rep = 0; rep < REP1; ++rep) pg8::gemm_phase<EpiSwiGLU, pg8::StaticOrder, true, true>(lds, gm, S, E);
    }
    SEAM(1);
    if (IN(2)) {
        pg8::Gemm gm{RH, (const bf16_t*)(ws + WS_W2_1), 16384, 2048, 5632}; pg8::StaticOrder S; S.init(16384, 2048, G, c);
        EpiResid E{p.in[0], p.out, RA, (float*)(ws + WS_SS2), 0.5f, 2048};
        pg8::gemm_phase<EpiResid, pg8::StaticOrder, true, true>(lds, gm, S, E);
    }
    SEAM(2);
    if (IN(3)) {
        { pg8::Gemm gm{RA, (const bf16_t*)(ws + WS_WIN), 16384, 5120, 2048}; pg8::StaticOrder S; S.init(16384, 5120, G, c);
          EpiScale E{RH, 5120, (const float*)(ws + WS_SS2)};
          pg8::gemm_phase<EpiScale, pg8::StaticOrder, true, true>(lds, gm, S, E); }
    }
    SEAM(3);
    if (IN(4)) {
        const int cm = (c + 128) % G; const bool split = (G >= 64);
        if (cm < 32) { pg8::Gemm gm{(const bf16_t*)(ws + WS_MEMB), (const bf16_t*)(ws + WS_WMEM), 2048, 1024, 2048}; pg8::StaticOrder S; S.init(2048, 1024, G, cm);
          EpiScale E{(bf16_t*)(ws + WS_MKV), 1024, (const float*)(ws + WS_SSM)};
          pg8::gemm_phase<EpiScale, pg8::StaticOrder, true, true>(lds, gm, S, E);
          pg8::Unit u; if (S.next(0, u)) mem_own_post(p, lds, u.pm, u.pn); }
        if (!split || cm >= 32) post_phase(p, lds, split ? cm - 32 : c, split ? G - 32 : G, true, false);
    }
    SEAM(4);
    if (IN(4) && !IN(5) && IN(6)) xcd_barrier(xbar);
    if (IN(6)) { for (int rep = 0; rep < REP5; ++rep) attn_phase(p, lds, rep); }
    SEAM(6);
    if (IN(7)) {
        pg8::Gemm gm{RA, (const bf16_t*)(ws + WS_WOUT), 16384, 2048, 2048}; pg8::StaticOrder S; S.init(16384, 2048, G, c);
        EpiResid E{p.out, p.out, RB, (float*)(ws + WS_SS3), 1.0f, 2048};
        pg8::gemm_phase<EpiResid, pg8::StaticOrder, true, true>(lds, gm, S, E);
    }
    SEAM(7);
    if (IN(8)) {
        pg8::Gemm gm{RB, (const bf16_t*)(ws + WS_W13_2), 16384, 11264, 2048}; pg8::StaticOrder S; S.init(16384, 11264, G, c);
        EpiSwiGLU E{RH, 5632, (const float*)(ws + WS_SS3)};
        pg8::gemm_phase<EpiSwiGLU, pg8::StaticOrder, true, true>(lds, gm, S, E);
    }
    SEAM(8);
    if (IN(9)) {
        pg8::Gemm gm{RH, (const bf16_t*)(ws + WS_W2_2), 16384, 2048, 5632}; pg8::StaticOrder S; S.init(16384, 2048, G, c);
        EpiResid E{p.out, p.out, nullptr, nullptr, 0.5f, 2048};
        pg8::gemm_phase<EpiResid, pg8::StaticOrder, true, true>(lds, gm, S, E);
    }
#undef IN
#undef SEAM
}

extern "C" void kernel_launch(void* const* d_in, const int* in_sizes, int n_in, void* d_out, int out_size, void* d_ws, size_t ws_size, hipStream_t stream) {
    static int grid = 0;
    if (grid == 0) {
        if (n_in != 23 || out_size != 16384 * 2048 || ws_size < WS_END) { fprintf(stderr, "kernel_launch: unexpected shapes / workspace (n_in %d out %d ws %zu need %zu)\n", n_in, out_size, ws_size, (size_t)WS_END); grid = -1; return; }
        int dev = 0, cus = 0, per_cu = 0;
        if (hipGetDevice(&dev) != hipSuccess || hipDeviceGetAttribute(&cus, hipDeviceAttributeMultiprocessorCount, dev) != hipSuccess) { grid = -1; return; }
        if (hipFuncSetAttribute((const void*)fwd_mega, hipFuncAttributeMaxDynamicSharedMemorySize, LDS_BYTES) != hipSuccess) { fprintf(stderr, "kernel_launch: hipFuncSetAttribute failed\n"); grid = -1; return; }
        if (hipOccupancyMaxActiveBlocksPerMultiprocessor(&per_cu, (const void*)fwd_mega, 512, LDS_BYTES) != hipSuccess || per_cu < 1) { fprintf(stderr, "kernel_launch: occupancy query says %d\n", per_cu); }
        (void)hipGetLastError();
        grid = cus;
    }
    if (grid < 0) return;
    Params p{};
    for (int i = 0; i < 23; ++i) p.in[i] = (const float*)d_in[i];
    p.out = (float*)d_out; p.ws = (unsigned char*)d_ws;
#if ONE_LAUNCH
    p.ph_lo = 0; p.ph_hi = NPHASE;
    void* args[] = {&p};
    if (hipMemsetAsync((unsigned char*)d_ws + WS_BAR, 0, 16384, stream) != hipSuccess) { fprintf(stderr, "kernel_launch: memset of the barrier words failed\n"); return; }
    hipError_t e = hipLaunchCooperativeKernel((const void*)fwd_mega, dim3(grid), dim3(512), args, LDS_BYTES, stream);
    if (e != hipSuccess) fprintf(stderr, "cooperative launch failed: %s (grid %d)\n", hipGetErrorString(e), grid);
#else
    for (int k = 0; k < NPHASE; ++k) { p.ph_lo = k; p.ph_hi = k + 1; hipLaunchKernelGGL(fwd_mega, dim3(grid), dim3(512), LDS_BYTES, stream, p); }
#endif
}
```

```cpp
#include <hip/hip_runtime.h>
#include <hip/hip_cooperative_groups.h>
#include <cstdio>
namespace cg = cooperative_groups;
namespace pg8 {
#define PG8_LAS __attribute__((address_space(3)))
typedef unsigned short bf16_t;
typedef short bf16x8 __attribute__((ext_vector_type(8)));
typedef float f32x4 __attribute__((ext_vector_type(4)));
typedef unsigned u32x4 __attribute__((ext_vector_type(4)));
constexpr int BM = 256, BK = 64, HALF = 128, HTB = HALF * BK * 2  , STAGE_BYTES = 8 * HTB, NXCD = 8, WGM = 6;

__host__ __device__ __forceinline__ int lds_byte(int r, int c) { const int st = (r >> 4) * 2 + (c >> 5), rr = r & 15, cc = c & 31, ob = rr * 64 + cc * 2; return st * 1024 + (ob ^ (((ob >> 9) & 1) << 5)); }
__host__ __device__ __forceinline__ void stage_rc(int b, int& R, int& C) { const int st = b / 1024, sb = b % 1024, swz = sb ^ (((sb >> 9) & 1) << 5); R = (st >> 1) * 16 + swz / 64; C = (st & 1) * 32 + (swz % 64) / 2; }
__host__ __device__ __forceinline__ int perm32(int rho) { const int n = rho >> 4, i = rho & 15; return 8 * (i >> 2) + 4 * n + (i & 3); }

struct Unit { int pm, pn; };
struct Gemm { const bf16_t* A; const bf16_t* Bt; int M, N, K; };

struct StaticOrder {
    int nM, nN, nwg, G, c;
    __host__ __device__ void init(int M, int N, int G_, int c_) { nM = M / BM; nN = N / BM; nwg = nM * nN; G = G_; c = c_; }
    __host__ __device__ bool next(int i, Unit& u) const {
        const long L = (long)i * G + c; if (L >= nwg) return false;
        int wgid = (int)L; { const int q = nwg / NXCD, r = nwg % NXCD, xcd = wgid % NXCD, off = wgid / NXCD; wgid = (xcd < r ? xcd * (q + 1) : r * (q + 1) + (xcd - r) * q) + off; }
        const int nig = WGM * nN, gid = wgid / nig, fm = gid * WGM, gsz = (nM - fm) < WGM ? (nM - fm) : WGM;
        u.pm = fm + ((wgid % nig) % gsz); u.pn = (wgid % nig) / gsz; return true;
    }
    __device__ __forceinline__ void a_ready(const Unit&) const {}
    __device__ __forceinline__ void done(const Unit&) const {}
};
__device__ __forceinline__ unsigned cvt_pk_bf16(float lo, float hi) { unsigned r; asm volatile("v_cvt_pk_bf16_f32 %0, %1, %2" : "=v"(r) : "v"(lo), "v"(hi)); return r; }
typedef float f32x2 __attribute__((ext_vector_type(2)));
template <class Epi, class Sched, bool ALIGN_EPI = false, bool SP2 = false>
__device__ __forceinline__ void gemm_phase(PG8_LAS unsigned char* lds, const Gemm g, const Sched& S, const Epi& E) {
    const int tid = threadIdx.x, wid = __builtin_amdgcn_readfirstlane(tid >> 6), lane = tid & 63, wr = wid >> 2, wc = wid & 3, fr = lane & 15, fq = lane >> 4;
    const int K = g.K, nt = K / BK;
    unsigned voffA[2], voffB[2];
#pragma unroll
    for (int i = 0; i < 2; ++i) { int R, C; stage_rc(tid * 16 + i * 8192, R, C); const int Rb = Epi::PERM ? ((R & ~31) + perm32(R & 31)) : R;
        voffA[i] = (unsigned)(R * K + C) * 2u; voffB[i] = (unsigned)(Rb * K + C) * 2u; }
    const size_t kstep = (size_t)(BK * 2);
    const size_t hstep = (size_t)HALF * K * 2;
    const size_t tstep = 2 * hstep;
    const unsigned ldsw = (unsigned)wid * 1024u;
    const int aoff = lds_byte(wr * 64 + fr, fq * 8), boff = lds_byte(wc * 32 + fr, fq * 8);
#define PG8_SA(b, h) (((b) * 2 + (h)) * HTB)
#define PG8_SB(b, h) ((4 + (b) * 2 + (h)) * HTB)
#define PG8_STAGE(bufoff, gbase, voff) do { _Pragma("unroll") for (int _i = 0; _i < 2; ++_i) \
        __builtin_amdgcn_global_load_lds((const unsigned*)((const char*)(gbase) + (voff)[_i]), (PG8_LAS unsigned*)(lds + (bufoff) + ldsw + _i * 8192), 16, 0, 0); } while (0)
#define PG8_LDA(dst, b, h) do { _Pragma("unroll") for (int m = 0; m < 4; ++m) _Pragma("unroll") for (int k = 0; k < 2; ++k) dst[m][k] = *(const PG8_LAS bf16x8*)(lds + PG8_SA(b, h) + aoff + m * 2048 + k * 1024); } while (0)
#define PG8_LDB(dst, b, h) do { _Pragma("unroll") for (int n = 0; n < 2; ++n) _Pragma("unroll") for (int k = 0; k < 2; ++k) dst[n][k] = *(const PG8_LAS bf16x8*)(lds + PG8_SB(b, h) + boff + n * 2048 + k * 1024); } while (0)
#define PG8_MMA(ai, bj, At, Bt) do { __builtin_amdgcn_s_setprio(1); _Pragma("unroll") for (int m = 0; m < 4; ++m) _Pragma("unroll") for (int n = 0; n < 2; ++n) _Pragma("unroll") for (int k = 0; k < 2; ++k) \
        acc[ai][bj][m][n] = __builtin_amdgcn_mfma_f32_16x16x32_bf16(Bt[n][k], At[m][k], acc[ai][bj][m][n], 0, 0, 0); __builtin_amdgcn_s_setprio(0); } while (0)
#define PG8_WAIT_V(n) asm volatile("s_waitcnt vmcnt(" #n ")" ::: "memory")
#define PG8_WAIT_L(n) asm volatile("s_waitcnt lgkmcnt(" #n ")" ::: "memory")
#define PG8_BAR __builtin_amdgcn_s_barrier()
#define PG8_SCHED __builtin_amdgcn_sched_barrier(0)
    Unit cur, nxt; int ui = 0;
    if (!S.next(0, cur)) return;
    f32x4 acc[2][2][4][2];
#pragma unroll
    for (int a = 0; a < 2; ++a)
#pragma unroll
        for (int b = 0; b < 2; ++b)
#pragma unroll
            for (int m = 0; m < 4; ++m)
#pragma unroll
                for (int n = 0; n < 2; ++n) acc[a][b][m][n] = (f32x4){0.f, 0.f, 0.f, 0.f};
    bf16x8 At[4][2], B0[2][2], B1[2][2];
    const char* cA = (const char*)g.A + (size_t)cur.pm * tstep; const char* cB = (const char*)g.Bt + (size_t)cur.pn * tstep;
    S.a_ready(cur);
    if constexpr (SP2) {
        PG8_STAGE(PG8_SB(0, 0), cB, voffB); PG8_STAGE(PG8_SB(0, 1), cB + hstep, voffB); PG8_STAGE(PG8_SA(0, 0), cA, voffA); PG8_STAGE(PG8_SA(0, 1), cA + hstep, voffA);
        if (wr == 1) PG8_BAR;
        PG8_WAIT_V(2); PG8_BAR;
        PG8_STAGE(PG8_SB(1, 0), cB + kstep, voffB); PG8_STAGE(PG8_SA(1, 0), cA + kstep, voffA); PG8_STAGE(PG8_SB(1, 1), cB + hstep + kstep, voffB);
        PG8_WAIT_V(6); PG8_BAR;
    } else {
        PG8_STAGE(PG8_SB(0, 0), cB, voffB); PG8_STAGE(PG8_SA(0, 0), cA, voffA); PG8_STAGE(PG8_SB(0, 1), cB + hstep, voffB); PG8_STAGE(PG8_SA(0, 1), cA + hstep, voffA);
        if (wr == 1) PG8_BAR;
        PG8_WAIT_V(4); PG8_BAR;
        PG8_STAGE(PG8_SB(1, 0), cB + kstep, voffB); PG8_STAGE(PG8_SA(1, 0), cA + kstep, voffA); PG8_STAGE(PG8_SB(1, 1), cB + hstep + kstep, voffB);
        PG8_WAIT_V(6); PG8_BAR;
    }
    for (;;) {
        const bool has_next = S.next(ui + 1, nxt);
        const char* nA = has_next ? (const char*)g.A + (size_t)nxt.pm * tstep : cA; const char* nB = has_next ? (const char*)g.Bt + (size_t)nxt.pn * tstep : cB;
        for (int t = 0; t < nt; t += 2) {
            const bool last = (t == nt - 2);
            const char* a1 = cA + (size_t)(t + 1) * kstep;
            const char* a2 = last ? nA : cA + (size_t)(t + 2) * kstep; const char* b2 = last ? nB : cB + (size_t)(t + 2) * kstep;
            const char* a3 = a2 + kstep; const char* b3 = b2 + kstep;
            if (last && has_next) S.a_ready(nxt);
            if constexpr (SP2) {
            PG8_LDB(B0, 0, 0); PG8_LDB(B1, 0, 1); PG8_SCHED; PG8_LDA(At, 0, 0); PG8_STAGE(PG8_SA(1, 1), a1 + hstep, voffA);
            PG8_WAIT_V(8); PG8_WAIT_L(0); PG8_BAR; PG8_MMA(0, 0, At, B0); PG8_MMA(0, 1, At, B1); PG8_BAR; PG8_SCHED;
            PG8_LDA(At, 0, 1); PG8_STAGE(PG8_SB(0, 0), b2, voffB); PG8_STAGE(PG8_SB(0, 1), b2 + hstep, voffB); PG8_STAGE(PG8_SA(0, 0), a2, voffA);
            PG8_WAIT_V(8); PG8_WAIT_L(0); PG8_BAR; PG8_MMA(1, 0, At, B0); PG8_MMA(1, 1, At, B1); PG8_BAR; PG8_SCHED;
            PG8_LDB(B0, 1, 0); PG8_LDB(B1, 1, 1); PG8_SCHED; PG8_LDA(At, 1, 0); PG8_STAGE(PG8_SA(0, 1), a2 + hstep, voffA);
            PG8_WAIT_V(8); PG8_WAIT_L(0); PG8_BAR; PG8_MMA(0, 0, At, B0); PG8_MMA(0, 1, At, B1); PG8_BAR; PG8_SCHED;
            PG8_LDA(At, 1, 1); PG8_STAGE(PG8_SB(1, 0), b3, voffB); PG8_STAGE(PG8_SB(1, 1), b3 + hstep, voffB); PG8_STAGE(PG8_SA(1, 0), a3, voffA);
            PG8_WAIT_V(8); PG8_WAIT_L(0); PG8_BAR; PG8_MMA(1, 0, At, B0); PG8_MMA(1, 1, At, B1); PG8_BAR; PG8_SCHED;
            } else {
            PG8_LDB(B0, 0, 0); PG8_SCHED; PG8_LDA(At, 0, 0); PG8_STAGE(PG8_SA(1, 1), a1 + hstep, voffA);
            PG8_WAIT_L(8); PG8_BAR; PG8_WAIT_L(0); PG8_MMA(0, 0, At, B0); PG8_BAR; PG8_SCHED;
            PG8_LDB(B1, 0, 1); PG8_STAGE(PG8_SB(0, 0), b2, voffB);
            PG8_BAR; PG8_WAIT_L(0); PG8_MMA(0, 1, At, B1); PG8_BAR;
            PG8_LDA(At, 0, 1); PG8_STAGE(PG8_SA(0, 0), a2, voffA);
            PG8_BAR; PG8_WAIT_L(0); PG8_MMA(1, 0, At, B0); PG8_BAR; PG8_SCHED;
            PG8_STAGE(PG8_SB(0, 1), b2 + hstep, voffB);
            PG8_WAIT_V(6); PG8_BAR; PG8_MMA(1, 1, At, B1); PG8_BAR;
            PG8_LDB(B0, 1, 0); PG8_SCHED; PG8_LDA(At, 1, 0); PG8_STAGE(PG8_SA(0, 1), a2 + hstep, voffA);
            PG8_WAIT_L(8); PG8_BAR; PG8_WAIT_L(0); PG8_MMA(0, 0, At, B0); PG8_BAR; PG8_SCHED;
            PG8_LDB(B1, 1, 1); PG8_STAGE(PG8_SB(1, 0), b3, voffB);
            PG8_BAR; PG8_WAIT_L(0); PG8_MMA(0, 1, At, B1); PG8_BAR;
            PG8_LDA(At, 1, 1); PG8_STAGE(PG8_SA(1, 0), a3, voffA);
            PG8_BAR; PG8_WAIT_L(0); PG8_MMA(1, 0, At, B0); PG8_BAR; PG8_SCHED;
            PG8_STAGE(PG8_SB(1, 1), b3 + hstep, voffB);
            PG8_WAIT_V(6); PG8_BAR; PG8_MMA(1, 1, At, B1); PG8_BAR;
            }
        }
        if constexpr (ALIGN_EPI) { if (wr == 0) PG8_BAR; }
        if constexpr (!Epi::AFTER_DRAIN) { E(acc, cur, wr, wc, fr, fq); S.done(cur); }
        if (!has_next) break;
#pragma unroll
        for (int a = 0; a < 2; ++a)
#pragma unroll
            for (int b = 0; b < 2; ++b)
#pragma unroll
                for (int m = 0; m < 4; ++m)
#pragma unroll
                    for (int n = 0; n < 2; ++n) acc[a][b][m][n] = (f32x4){0.f, 0.f, 0.f, 0.f};
        cur = nxt; cA = nA; cB = nB; ++ui;
        if constexpr (ALIGN_EPI) { if (wr == 1) PG8_BAR; }
    }
    PG8_WAIT_V(0);
    if constexpr (!ALIGN_EPI) { if (wr == 0) PG8_BAR; }
    PG8_BAR;
    if constexpr (Epi::AFTER_DRAIN) { E.fused(acc, cur, wr, wc, fr, fq, lds, wid, lane); S.done(cur); }
#undef PG8_SA
#undef PG8_SB
#undef PG8_STAGE
#undef PG8_LDA
#undef PG8_LDB
#undef PG8_MMA
#undef PG8_WAIT_V
#undef PG8_WAIT_L
#undef PG8_BAR
#undef PG8_SCHED
}
}
#define LAS __attribute__((address_space(3)))
#define XB_TMO      128
#define XB_XCNT(j)  (256  + 64 * (j))
#define XB_XSUB(j)  (1280 + 64 * (j))
#define XB_XGEN(j)  (2304 + 64 * (j))
#define XB_TOP      3328
#define XB_TOPGEN   3392
#define XCD_BAR_WORDS 3456
#define XB_SPIN_CAP (1u << 18)

__device__ __forceinline__ unsigned xb_ld(unsigned* p)              { return __hip_atomic_load(p, __ATOMIC_RELAXED, __HIP_MEMORY_SCOPE_AGENT); }
__device__ __forceinline__ unsigned xb_add(unsigned* p, unsigned v) { return __hip_atomic_fetch_add(p, v, __ATOMIC_RELAXED, __HIP_MEMORY_SCOPE_AGENT); }
__device__ __forceinline__ unsigned xb_xcc_id() { return (unsigned)__builtin_amdgcn_s_getreg((3 << 11) | 20) & 0xFu; }
#define XB_SPIN(cond, bar) do { unsigned _sp = 0; while (cond) { __builtin_amdgcn_s_sleep(1); \
    if ((++_sp & 255u) == 0u) { if (xb_ld(&(bar)[XB_TMO])) break; if (_sp > XB_SPIN_CAP) { atomicAdd(&(bar)[XB_TMO], 1u); break; } } } } while (0)

struct XcdBarrier {
    unsigned* bar; unsigned x;
    volatile LAS unsigned* st;
};

__device__ __forceinline__ XcdBarrier xcd_barrier_post(unsigned* bar, volatile LAS unsigned* st) {
    XcdBarrier b; b.bar = bar; b.x = xb_xcc_id(); b.st = st;
    if (threadIdx.x == 0) (void)xb_add(&bar[XB_XCNT(b.x)], 1u);
    return b;
}
__device__ __forceinline__ void xcd_barrier_complete(unsigned* bar, unsigned x, unsigned& nloc, unsigned& nx) {
    const unsigned G = gridDim.x * gridDim.y * gridDim.z;
    unsigned sum, cnt, mine, sp = 0u;
    for (;;) {
        sum = 0u; cnt = 0u; mine = 0u;
#pragma unroll
        for (unsigned j = 0; j < 16; ++j) { const unsigned c = xb_ld(&bar[XB_XCNT(j)]); sum += c; cnt += (c > 0u) ? 1u : 0u; mine = (j == x) ? c : mine; }
        if (sum == G) break;
        __builtin_amdgcn_s_sleep(1);
        if ((++sp & 255u) == 0u) { if (xb_ld(&bar[XB_TMO])) break; if (sp > XB_SPIN_CAP) { atomicAdd(&bar[XB_TMO], 1u); break; } }
    }
    nloc = mine > 0u ? mine : 1u; nx = cnt > 0u ? cnt : 1u;
}

__device__ __forceinline__ void xcd_barrier(const XcdBarrier& b) {
    asm volatile("s_waitcnt vmcnt(0)" ::: "memory");
    __syncthreads();
    if (threadIdx.x == 0) {
        unsigned* bar = b.bar;
        __builtin_amdgcn_s_waitcnt(0);
        unsigned nloc = b.st[0], nx = b.st[1];
        if (nloc == 0u) { xcd_barrier_complete(bar, b.x, nloc, nx); b.st[0] = nloc; b.st[1] = nx; }
        const unsigned old = xb_add(&bar[XB_XSUB(b.x)], 1u);
        const unsigned gen = old / nloc;
        if (old + 1u == (gen + 1u) * nloc) {
            __builtin_amdgcn_fence(__ATOMIC_RELEASE, "agent");
            asm volatile("s_waitcnt vmcnt(0)" ::: "memory");
            const unsigned og = xb_add(&bar[XB_TOP], 1u);
            const unsigned tg = og / nx;
            if (og + 1u == (tg + 1u) * nx) xb_add(&bar[XB_TOPGEN], 1u);
            else XB_SPIN(xb_ld(&bar[XB_TOPGEN]) == tg, bar);
            __builtin_amdgcn_fence(__ATOMIC_ACQUIRE, "agent");
            xb_add(&bar[XB_XGEN(b.x)], 1u);
            asm volatile("s_waitcnt vmcnt(0)" ::: "memory");
        } else {
            XB_SPIN(xb_ld(&bar[XB_XGEN(b.x)]) == gen, bar);
            __builtin_amdgcn_fence(__ATOMIC_ACQUIRE, "agent");
            asm volatile("s_waitcnt vmcnt(0)" ::: "memory");
        }
    }
    __syncthreads();
}


using pg8::bf16_t; using pg8::bf16x8; using pg8::f32x4; using pg8::u32x4;

typedef unsigned u32x2 __attribute__((ext_vector_type(2)));

#ifndef ONE_LAUNCH
#define ONE_LAUNCH 1
#endif
constexpr int NPHASE = 10;
#ifndef DEFER_CONV
#define DEFER_CONV 1
#endif
#ifndef REP0
#define REP0 1
#endif
#ifndef REP1
#define REP1 1
#endif
#ifndef REP5
#define REP5 1
#endif
constexpr float EPS = 1e-6f;
constexpr float LOG2E = 1.4426950408889634f;
constexpr int LDS_BYTES = 139264;

constexpr size_t SZ_W13 = (size_t)11264 * 2048 * 2, SZ_W2 = (size_t)2048 * 5632 * 2;
constexpr size_t WS_W13_1 = 0;
constexpr size_t WS_W2_1 = WS_W13_1 + SZ_W13;
constexpr size_t WS_W13_2 = WS_W2_1 + SZ_W2;
constexpr size_t WS_W2_2 = WS_W13_2 + SZ_W13;
constexpr size_t WS_WIN = WS_W2_2 + SZ_W2;
constexpr size_t WS_WOUT = WS_WIN + (size_t)5120 * 2048 * 2;
constexpr size_t WS_WMEM = WS_WOUT + (size_t)2048 * 2048 * 2;
constexpr size_t WS_WFF = WS_WMEM + (size_t)1024 * 2048 * 2;
constexpr size_t WS_RA = WS_WFF + 65536;
constexpr size_t WS_RB = WS_RA + (size_t)16384 * 2048 * 2;
constexpr size_t WS_RH = WS_RB + (size_t)16384 * 2048 * 2;
constexpr size_t WS_MEMB = WS_RH + (size_t)16384 * 5632 * 2;
constexpr size_t WS_MKV = WS_MEMB + (size_t)2048 * 2048 * 2;
constexpr size_t WS_SS1 = WS_MKV + (size_t)2048 * 1024 * 2;
constexpr size_t WS_SS2 = WS_SS1 + 65536;
constexpr size_t WS_SS3 = WS_SS2 + 65536;
constexpr size_t WS_SSM = WS_SS3 + 65536;
constexpr size_t WS_LOGF = WS_SSM + 8192;
constexpr size_t WS_KMEAN = WS_LOGF + 524288;
constexpr size_t WS_CTR = WS_KMEAN + 131072;
constexpr size_t WS_BAR = WS_CTR + 256;
constexpr size_t WS_BND = WS_BAR + 16384;
constexpr size_t WS_END = WS_BND + 256;

struct Params { const float* in[23]; float* out; unsigned char* ws; int ph_lo, ph_hi; };

__device__ __forceinline__ float wave_sum(float v) {
#pragma unroll
    for (int o = 1; o < 64; o <<= 1) v += __shfl_xor(v, o);
    return v;
}
__device__ __forceinline__ unsigned pk2(float a, float b) { return pg8::cvt_pk_bf16(a, b); }
__device__ __forceinline__ float bf_lo(unsigned u) { return __uint_as_float(u << 16); }
__device__ __forceinline__ float bf_hi(unsigned u) { return __uint_as_float(u & 0xffff0000u); }
__device__ __forceinline__ float rstd_of(float ss, float invn) { return 1.0f / sqrtf(ss * invn + EPS); }

struct EpiSwiGLU {
    static constexpr bool PERM = true, AFTER_DRAIN = false;
    bf16_t* H; int ldh; const float* ss;
    __device__ __forceinline__ void operator()(const f32x4 (&acc)[2][2][4][2], const pg8::Unit& u, int wr, int wc, int fr, int fq) const {
        const int row0 = u.pm * 256 + wr * 64 + fr, col0 = u.pn * 128 + wc * 32 + 8 * fq;
#pragma unroll
        for (int ai = 0; ai < 2; ++ai)
#pragma unroll
            for (int m = 0; m < 4; ++m) {
                const int row = row0 + ai * 128 + m * 16;
                const float rs = ss ? rstd_of(ss[row], 1.0f / 2048.0f) : 1.0f;
                u32x4 w;
                unsigned wv[4];
#pragma unroll
                for (int n = 0; n < 2; ++n) {
                    const f32x4 gt = acc[ai][0][m][n] * rs, up = acc[ai][1][m][n] * rs;
                    float hv[4];
#pragma unroll
                    for (int j = 0; j < 4; ++j) { const float e = __builtin_amdgcn_exp2f(-gt[j] * LOG2E); hv[j] = gt[j] * __builtin_amdgcn_rcpf(1.0f + e) * up[j]; }
                    wv[2 * n] = pk2(hv[0], hv[1]); wv[2 * n + 1] = pk2(hv[2], hv[3]);
                }
                w.x = wv[0]; w.y = wv[1]; w.z = wv[2]; w.w = wv[3];
                *(u32x4*)(H + (size_t)row * ldh + col0) = w;
            }
    }
};
struct EpiResid {
    static constexpr bool PERM = true, AFTER_DRAIN = false;
    const float* base; float* out; bf16_t* ob; float* ssq; float alpha; int ld;
    __device__ __forceinline__ void operator()(const f32x4 (&acc)[2][2][4][2], const pg8::Unit& u, int wr, int wc, int fr, int fq) const {
        const int row0 = u.pm * 256 + wr * 64 + fr, col0 = u.pn * 256 + wc * 32 + 8 * fq;
#pragma unroll
        for (int ai = 0; ai < 2; ++ai) {
            f32x4 r0[4][2], r1[4][2];
#pragma unroll
            for (int m = 0; m < 4; ++m)
#pragma unroll
                for (int bj = 0; bj < 2; ++bj) { const size_t off = (size_t)(row0 + ai * 128 + m * 16) * ld + col0 + bj * 128;
                    r0[m][bj] = __builtin_nontemporal_load((const f32x4*)(base + off)); r1[m][bj] = __builtin_nontemporal_load((const f32x4*)(base + off + 4)); }
#pragma unroll
            for (int m = 0; m < 4; ++m) {
                const int row = row0 + ai * 128 + m * 16; const size_t off = (size_t)row * ld + col0;
                float s = 0.f;
#pragma unroll
                for (int bj = 0; bj < 2; ++bj) {
                    const f32x4 v0 = r0[m][bj] + acc[ai][bj][m][0] * alpha, v1 = r1[m][bj] + acc[ai][bj][m][1] * alpha;
                    __builtin_nontemporal_store(v0, (f32x4*)(out + off + bj * 128)); __builtin_nontemporal_store(v1, (f32x4*)(out + off + bj * 128 + 4));
                    if (ob) { u32x4 w; w.x = pk2(v0[0], v0[1]); w.y = pk2(v0[2], v0[3]); w.z = pk2(v1[0], v1[1]); w.w = pk2(v1[2], v1[3]); *(u32x4*)(ob + off + bj * 128) = w; }
                    s += (v0[0] * v0[0] + v0[1] * v0[1]) + (v0[2] * v0[2] + v0[3] * v0[3]) + (v1[0] * v1[0] + v1[1] * v1[1]) + (v1[2] * v1[2] + v1[3] * v1[3]);
                }
                if (ssq) { s += __shfl_xor(s, 16); s += __shfl_xor(s, 32); if (fq == 0) atomicAdd(ssq + row, s); }
            }
            asm volatile("" ::: "memory");
        }
    }
};
struct EpiScale {
    static constexpr bool PERM = true, AFTER_DRAIN = false;
    bf16_t* O; int ldc; const float* ss;
    __device__ __forceinline__ void operator()(const f32x4 (&acc)[2][2][4][2], const pg8::Unit& u, int wr, int wc, int fr, int fq) const {
        const int row0 = u.pm * 256 + wr * 64 + fr, col0 = u.pn * 256 + wc * 32 + 8 * fq;
#pragma unroll
        for (int ai = 0; ai < 2; ++ai)
#pragma unroll
            for (int m = 0; m < 4; ++m) {
                const int row = row0 + ai * 128 + m * 16;
                const float rs = rstd_of(ss[row], 1.0f / 2048.0f);
#pragma unroll
                for (int bj = 0; bj < 2; ++bj) {
                    const f32x4 v0 = acc[ai][bj][m][0] * rs, v1 = acc[ai][bj][m][1] * rs;
                    u32x4 w; w.x = pk2(v0[0], v0[1]); w.y = pk2(v0[2], v0[3]); w.z = pk2(v1[0], v1[1]); w.w = pk2(v1[2], v1[3]);
                    *(u32x4*)(O + (size_t)row * ldc + col0 + bj * 128) = w;
                }
            }
    }
};

struct TrItem { const float* W; const float* gain; bf16_t* WT; int ldw, col0, K, drow0, k0; };
__device__ __forceinline__ void tr_decode(const Params& p, int it, TrItem& t) {
    unsigned char* ws = p.ws;
    constexpr int I_W1 = 32 * 88, I_W2 = 88 * 32, I_INA = 32 * 48, I_INB = 32 * 32, I_OUT = 32 * 32;
    int r = it;
    if (r < 4 * I_W1) { const int which = r / I_W1; r -= which * I_W1; const int kb = r / 88, nb = r % 88, n0 = 64 * nb;
        const float *w0 = p.in[3], *w1 = p.in[4], *w2 = p.in[19], *w3 = p.in[20], *ga = p.in[2], *gb = p.in[18];
        asm volatile("" : "+s"(w0), "+s"(w1), "+s"(w2), "+s"(w3), "+s"(ga), "+s"(gb));
        t.W = which == 0 ? w0 : which == 1 ? w1 : which == 2 ? w2 : w3; t.gain = which < 2 ? ga : gb;
        t.WT = (bf16_t*)(ws + (which < 2 ? WS_W13_1 : WS_W13_2)); t.ldw = 5632; t.col0 = n0; t.K = 2048; t.drow0 = 256 * (n0 >> 7) + 128 * (which & 1) + (n0 & 127); t.k0 = 64 * kb; return; }
    r -= 4 * I_W1;
    if (r < 2 * I_W2) { const int which = r / I_W2; r -= which * I_W2; const int kb = r / 32, nb = r % 32;
        const float *w0 = p.in[5], *w1 = p.in[21]; asm volatile("" : "+s"(w0), "+s"(w1));
        t.W = which ? w1 : w0; t.gain = nullptr; t.WT = (bf16_t*)(ws + (which ? WS_W2_2 : WS_W2_1)); t.ldw = 2048; t.col0 = 64 * nb; t.K = 5632; t.drow0 = 64 * nb; t.k0 = 64 * kb; return; }
    r -= 2 * I_W2;
    if (r < I_INA) { const int kb = r / 48, nb = r % 48; t.W = p.in[8]; t.gain = p.in[6]; t.WT = (bf16_t*)(ws + WS_WIN); t.ldw = 5128; t.col0 = 64 * nb; t.K = 2048; t.drow0 = 64 * nb; t.k0 = 64 * kb; return; }
    r -= I_INA;
    if (r < I_INB) { const int kb = r / 32, nb = r % 32; t.W = p.in[8]; t.gain = p.in[6]; t.WT = (bf16_t*)(ws + WS_WIN); t.ldw = 5128; t.col0 = 3080 + 64 * nb; t.K = 2048; t.drow0 = 3072 + 64 * nb; t.k0 = 64 * kb; return; }
    r -= I_INB;
    if (r < I_OUT) { const int kb = r / 32, nb = r % 32; t.W = p.in[17]; t.gain = nullptr; t.WT = (bf16_t*)(ws + WS_WOUT); t.ldw = 2048; t.col0 = 64 * nb; t.K = 2048; t.drow0 = 64 * nb; t.k0 = 64 * kb; return; }
    r -= I_OUT;
    { const int kb = r / 16, nb = r % 16; t.W = p.in[10]; t.gain = p.in[7]; t.WT = (bf16_t*)(ws + WS_WMEM); t.ldw = 1024; t.col0 = 64 * nb; t.K = 2048; t.drow0 = 64 * nb; t.k0 = 64 * kb; }
}
#define TR_LOAD(t) do { const float* _b = (t).W + (size_t)((t).k0 + (lane >> 4)) * (t).ldw + (t).col0 + (lane & 15) * 4; \
        _Pragma("unroll") for (int _i = 0; _i < 16; ++_i) v[_i] = __builtin_nontemporal_load((const f32x4*)(_b + (size_t)(4 * _i) * (t).ldw)); } while (0)
constexpr int TR_N0 = 11520, TR_N1 = 9472;
__device__ __forceinline__ int tr_id(int set, int j) {
    if (set == 0) return j < 5632 ? j : j < 8448 ? 11264 + (j - 5632) : j < 11008 ? 16896 + (j - 8448) : 20480 + (j - 11008);
    return j < 5632 ? 5632 + j : j < 8448 ? 14080 + (j - 5632) : 19456 + (j - 8448);
}
__device__ __forceinline__ void tr_run(const Params& p, LAS float* scr, int lane, int set, int j0, int jend, int stride) {
    f32x4 v[16]; TrItem cur, nxt;
    int it = j0;
    if (it < jend) { tr_decode(p, tr_id(set, it), cur); TR_LOAD(cur); }
    while (it < jend) {
        const int kq = lane >> 4, n4 = (lane & 15) * 4;
#pragma unroll
        for (int i = 0; i < 16; ++i) { const int k = 4 * i + kq;
            scr[(n4 + 0) * 65 + k] = v[i][0]; scr[(n4 + 1) * 65 + k] = v[i][1]; scr[(n4 + 2) * 65 + k] = v[i][2]; scr[(n4 + 3) * 65 + k] = v[i][3]; }
        const int itn = it + stride;
        if (itn < jend) { tr_decode(p, tr_id(set, itn), nxt); TR_LOAD(nxt); }
        asm volatile("s_waitcnt lgkmcnt(0)" ::: "memory");
        const int c = lane & 7;
        f32x4 g0 = {1.f, 1.f, 1.f, 1.f}, g1 = {1.f, 1.f, 1.f, 1.f};
        if (cur.gain) { g0 = *(const f32x4*)(cur.gain + cur.k0 + 8 * c); g1 = *(const f32x4*)(cur.gain + cur.k0 + 8 * c + 4); }
#pragma unroll
        for (int j = 0; j < 8; ++j) { const int n = (lane >> 3) + 8 * j; const LAS float* s = scr + n * 65 + 8 * c;
            u32x4 o; o.x = pk2(s[0] * g0[0], s[1] * g0[1]); o.y = pk2(s[2] * g0[2], s[3] * g0[3]); o.z = pk2(s[4] * g1[0], s[5] * g1[1]); o.w = pk2(s[6] * g1[2], s[7] * g1[3]);
            *(u32x4*)(cur.WT + (size_t)(cur.drow0 + n) * cur.K + cur.k0 + 8 * c) = o; }
        asm volatile("s_waitcnt lgkmcnt(0)" ::: "memory");
        cur = nxt; it = itn;
    }
}
__device__ __forceinline__ void phase0(const Params& p, LAS unsigned char* lds) {
    const int tid = threadIdx.x, lane = tid & 63, wave = __builtin_amdgcn_readfirstlane(tid >> 6);
    const int gw = blockIdx.x * 8 + wave, NGW = gridDim.x * 8;
    LAS float* scr = (LAS float*)(lds + wave * 16640);
    unsigned char* ws = p.ws;
    tr_run(p, scr, lane, DEFER_CONV ? 0 : 0, gw, TR_N0, NGW);
    if (!DEFER_CONV) tr_run(p, scr, lane, 1, gw, TR_N1, NGW);
    for (int m2 = gw; m2 < (16384 + 2048) / 2; m2 += NGW) {
        const int m = 2 * m2; const bool ismem = m >= 16384; const int r = ismem ? m - 16384 : m;
        const float *px = p.in[0], *pm = p.in[1]; asm volatile("" : "+s"(px), "+s"(pm));
        const f32x4* src = (const f32x4*)((ismem ? pm : px) + (size_t)r * 2048);
        u32x2* dst = (u32x2*)((bf16_t*)(ws + (ismem ? WS_MEMB : WS_RA)) + (size_t)r * 2048);
        f32x4 a[8], bq[8];
#pragma unroll
        for (int j = 0; j < 8; ++j) { a[j] = __builtin_nontemporal_load(src + lane + 64 * j); bq[j] = __builtin_nontemporal_load(src + 512 + lane + 64 * j); }
        float s0 = 0.f, s1 = 0.f;
#pragma unroll
        for (int j = 0; j < 8; ++j) { const f32x4 x = a[j], y = bq[j];
            s0 += (x[0] * x[0] + x[1] * x[1]) + (x[2] * x[2] + x[3] * x[3]); s1 += (y[0] * y[0] + y[1] * y[1]) + (y[2] * y[2] + y[3] * y[3]); }
        s0 = wave_sum(s0); s1 = wave_sum(s1);
        const float r0 = ismem ? 1.0f : rstd_of(s0, 1.0f / 2048.0f), r1 = ismem ? 1.0f : rstd_of(s1, 1.0f / 2048.0f);
#pragma unroll
        for (int j = 0; j < 8; ++j) { const f32x4 x = a[j] * r0, y = bq[j] * r1;
            u32x2 o; o.x = pk2(x[0], x[1]); o.y = pk2(x[2], x[3]); dst[lane + 64 * j] = o;
            u32x2 q; q.x = pk2(y[0], y[1]); q.y = pk2(y[2], y[3]); dst[512 + lane + 64 * j] = q; }
        if (lane == 0 && ismem) { float* so = (float*)(ws + WS_SSM); so[r] = s0; so[r + 1] = s1; }
    }
    const int gt = blockIdx.x * 512 + tid, NGT = gridDim.x * 512;
    for (int i = gt; i < 16384; i += NGT) { ((float*)(ws + WS_SS2))[i] = 0.f; ((float*)(ws + WS_SS3))[i] = 0.f;
        const int h = i >> 11, k = i & 2047; ((float*)(ws + WS_WFF))[i] = p.in[6][k] * p.in[8][(size_t)k * 5128 + 3072 + h]; }
    for (int i = gt; i < 32768; i += NGT) ((float*)(ws + WS_KMEAN))[i] = 0.f;
    if (gt < 8) ((unsigned*)(ws + WS_CTR))[gt] = 0u;
    if (blockIdx.x == 0 && wave < 3) {
        const float* gq = wave == 0 ? p.in[11] : wave == 1 ? p.in[13] : p.in[15]; const float* gk = wave == 0 ? p.in[12] : wave == 1 ? p.in[14] : p.in[16];
        float mq = fmaxf(fabsf(gq[lane]), fabsf(gq[lane + 64])), mk = fmaxf(fabsf(gk[lane]), fabsf(gk[lane + 64])), mb = fmaxf(fabsf(p.in[22][lane]), fabsf(p.in[22][lane + 64]));
#pragma unroll
        for (int o = 1; o < 64; o <<= 1) { mq = fmaxf(mq, __shfl_xor(mq, o)); mk = fmaxf(mk, __shfl_xor(mk, o)); mb = fmaxf(mb, __shfl_xor(mb, o)); }
        if (lane == 0) ((float*)(ws + WS_BND))[wave] = 128.0f * 0.08838834764831845f * LOG2E * mq * mk * 1.02f + (wave == 1 ? mb * LOG2E : 0.f);
    }
}

struct F8 { f32x4 a, b; };
__device__ __forceinline__ F8 headnorm_r(const u32x4 raw, const f32x4 g0, const f32x4 g1, u32x4& packed) {
    f32x4 a = {bf_lo(raw.x), bf_hi(raw.x), bf_lo(raw.y), bf_hi(raw.y)}, b = {bf_lo(raw.z), bf_hi(raw.z), bf_lo(raw.w), bf_hi(raw.w)};
    float s = (a[0] * a[0] + a[1] * a[1]) + (a[2] * a[2] + a[3] * a[3]) + (b[0] * b[0] + b[1] * b[1]) + (b[2] * b[2] + b[3] * b[3]);
    s += __shfl_xor(s, 1); s += __shfl_xor(s, 2); s += __shfl_xor(s, 4); s += __shfl_xor(s, 8);
    const float r = rstd_of(s, 1.0f / 128.0f);
    a = a * r * g0; b = b * r * g1;
    packed.x = pk2(a[0], a[1]); packed.y = pk2(a[2], a[3]); packed.z = pk2(b[0], b[1]); packed.w = pk2(b[2], b[3]);
    F8 res; res.a = a; res.b = b; return res;
}
__device__ __forceinline__ void vt_tile(bf16_t* base, int pitch, LAS unsigned short* T, int lane) {
    u32x4 v[16];
#pragma unroll
    for (int i = 0; i < 16; ++i) { const int c = lane + 64 * i, r = c >> 4, cc = c & 15; v[i] = *(const u32x4*)(base + (size_t)r * pitch + cc * 8); }
#pragma unroll
    for (int i = 0; i < 16; ++i) { const int c = lane + 64 * i, r = c >> 4, cc = c & 15;
        LAS unsigned* w = (LAS unsigned*)(T + r * 130 + cc * 8);
        w[0] = v[i].x; w[1] = v[i].y; w[2] = v[i].z; w[3] = v[i].w; }
    asm volatile("s_waitcnt lgkmcnt(0)" ::: "memory");
#pragma unroll
    for (int i = 0; i < 16; ++i) { const int c = lane + 64 * i, r = c >> 4, cc = c & 15, d = 2 * r + (cc >> 3), k0 = 8 * (cc & 7);
        const int kc = k0 >> 3, kbase = 32 * (kc >> 2) + 4 * (kc & 3);
        const LAS unsigned short* s = T + kbase * 130 + d;
        u32x4 o;
        o.x = (unsigned)s[0 * 130] | ((unsigned)s[1 * 130] << 16); o.y = (unsigned)s[2 * 130] | ((unsigned)s[3 * 130] << 16);
        o.z = (unsigned)s[16 * 130] | ((unsigned)s[17 * 130] << 16); o.w = (unsigned)s[18 * 130] | ((unsigned)s[19 * 130] << 16);
        *(u32x4*)(base + (size_t)r * pitch + cc * 8) = o; }
    asm volatile("s_waitcnt lgkmcnt(0)" ::: "memory");
}
struct PostRow { u32x4 c0, c1, c2, c3, c6, c7, c9; u32x2 x[8]; };
#define POST_LOAD(R, row) do { const bf16_t* _P = proj + (size_t)(row) * 5120 + lane * 8; const bf16_t* _X = x1b + (size_t)(row) * 2048 + lane * 4; \
        R.c0 = *(const u32x4*)(_P); R.c1 = *(const u32x4*)(_P + 512); R.c2 = *(const u32x4*)(_P + 1024); R.c3 = *(const u32x4*)(_P + 1536); \
        R.c6 = *(const u32x4*)(_P + 3072); R.c7 = *(const u32x4*)(_P + 3584); R.c9 = *(const u32x4*)(_P + 4608); \
        _Pragma("unroll") for (int _j = 0; _j < 8; ++_j) R.x[_j] = __builtin_nontemporal_load((const u32x2*)(_X + 256 * _j)); } while (0)
__device__ __forceinline__ void post_phase(const Params& p, LAS unsigned char* lds, int rb, int nb, bool do_ab, bool do_c) {
    const int tid = threadIdx.x, lane = tid & 63, wave = __builtin_amdgcn_readfirstlane(tid >> 6);
    const int gw = blockIdx.x * 8 + wave, NGW = gridDim.x * 8;
    const int w = rb * 8 + wave, W = nb * 8;
    unsigned char* ws = p.ws;
    bf16_t* proj = (bf16_t*)(ws + WS_RH); bf16_t* mkv = (bf16_t*)(ws + WS_MKV);
    const bf16_t* x1b = (const bf16_t*)(ws + WS_RA);
    const float* ss2 = (const float*)(ws + WS_SS2); const float* wff = (const float*)(ws + WS_WFF);
    float* logf_ = (float*)(ws + WS_LOGF); float* kmean = (float*)(ws + WS_KMEAN);
    LAS float* wl = (LAS float*)lds;
    if (do_ab) {
#pragma unroll
    for (int i = 0; i < 8; ++i) *(LAS f32x4*)(wl + (tid + 512 * i) * 4) = *(const f32x4*)(wff + (tid + 512 * i) * 4);
    }
    __syncthreads();
    const int go = (lane & 15) * 8;
    const float QSC = 0.08838834764831845f * LOG2E;
    const f32x4 gfq0 = *(const f32x4*)(p.in[11] + go) * QSC, gfq1 = *(const f32x4*)(p.in[11] + go + 4) * QSC, gfk0 = *(const f32x4*)(p.in[12] + go), gfk1 = *(const f32x4*)(p.in[12] + go + 4);
    const f32x4 gbq0 = *(const f32x4*)(p.in[13] + go) * QSC, gbq1 = *(const f32x4*)(p.in[13] + go + 4) * QSC, gbk0 = *(const f32x4*)(p.in[14] + go), gbk1 = *(const f32x4*)(p.in[14] + go + 4);
    const f32x4 gcq0 = *(const f32x4*)(p.in[15] + go) * QSC, gcq1 = *(const f32x4*)(p.in[15] + go + 4) * QSC;
    if (do_ab) {
        const int r0 = (int)(((long long)w * 16384) / W), r1 = (int)(((long long)(w + 1) * 16384) / W);
        f32x4 ka = {0.f, 0.f, 0.f, 0.f}, kb = {0.f, 0.f, 0.f, 0.f};
        PostRow cur, nxt;
        if (r0 < r1) POST_LOAD(cur, r0);
        for (int row = r0; row < r1; ++row) {
            if (row + 1 < r1) POST_LOAD(nxt, row + 1);
            bf16_t* P = proj + (size_t)row * 5120 + lane * 8;
            u32x4 o;
            headnorm_r(cur.c0, gfq0, gfq1, o); *(u32x4*)(P) = o;
            headnorm_r(cur.c1, gfq0, gfq1, o); *(u32x4*)(P + 512) = o;
            headnorm_r(cur.c2, gfk0, gfk1, o); *(u32x4*)(P + 1024) = o;
            headnorm_r(cur.c3, gfk0, gfk1, o); *(u32x4*)(P + 1536) = o;
            headnorm_r(cur.c6, gbq0, gbq1, o); *(u32x4*)(P + 3072) = o;
            { const F8 kk = headnorm_r(cur.c7, gbk0, gbk1, o); *(u32x4*)(P + 3584) = o; ka += kk.a; kb += kk.b; }
            headnorm_r(cur.c9, gcq0, gcq1, o); *(u32x4*)(P + 4608) = o;
            float d0 = 0.f, d1 = 0.f, d2 = 0.f, d3 = 0.f, d4 = 0.f, d5 = 0.f, d6 = 0.f, d7 = 0.f;
#pragma unroll
            for (int j = 0; j < 8; ++j) {
                const f32x4 xa = {bf_lo(cur.x[j].x), bf_hi(cur.x[j].x), bf_lo(cur.x[j].y), bf_hi(cur.x[j].y)};
                const LAS float* wp = wl + 256 * j + 4 * lane;
#define FF_DOT(H, D) { const f32x4 w0 = *(const LAS f32x4*)(wp + (H) * 2048); D += (xa[0] * w0[0] + xa[1] * w0[1]) + (xa[2] * w0[2] + xa[3] * w0[3]); }
                FF_DOT(0, d0) FF_DOT(1, d1) FF_DOT(2, d2) FF_DOT(3, d3) FF_DOT(4, d4) FF_DOT(5, d5) FF_DOT(6, d6) FF_DOT(7, d7)
#undef FF_DOT
            }
            d0 = wave_sum(d0); d1 = wave_sum(d1); d2 = wave_sum(d2); d3 = wave_sum(d3); d4 = wave_sum(d4); d5 = wave_sum(d5); d6 = wave_sum(d6); d7 = wave_sum(d7);
            if (lane < 8) {
                const float dv = lane == 0 ? d0 : lane == 1 ? d1 : lane == 2 ? d2 : lane == 3 ? d3 : lane == 4 ? d4 : lane == 5 ? d5 : lane == 6 ? d6 : d7;
                const float z = dv * rstd_of(ss2[row], 1.0f / 2048.0f) + p.in[9][lane];
                logf_[(size_t)row * 8 + lane] = fminf(z, 0.f) - log1pf(__expf(-fabsf(z)));
            }
            cur = nxt;
            if ((row & 255) == 255 || row + 1 == r1) {
                const int b = row >> 11, blk = (row & 2047) >> 8, h = lane >> 4;
                float* km = kmean + ((size_t)((b * 4 + h) * 8 + blk)) * 128 + (lane & 15) * 8;
                const float sc = 1.0f / 256.0f;
                atomicAdd(km + 0, ka[0] * sc); atomicAdd(km + 1, ka[1] * sc); atomicAdd(km + 2, ka[2] * sc); atomicAdd(km + 3, ka[3] * sc);
                atomicAdd(km + 4, kb[0] * sc); atomicAdd(km + 5, kb[1] * sc); atomicAdd(km + 6, kb[2] * sc); atomicAdd(km + 7, kb[3] * sc);
                ka = (f32x4){0.f, 0.f, 0.f, 0.f}; kb = (f32x4){0.f, 0.f, 0.f, 0.f};
            }
        }
    }
    if (do_c) { const f32x4 g0 = *(const f32x4*)(p.in[16] + go), g1 = *(const f32x4*)(p.in[16] + go + 4);
      for (int row = gw; row < 2048; row += NGW) { bf16_t* P = mkv + (size_t)row * 1024 + lane * 8; u32x4 o; headnorm_r(*(const u32x4*)P, g0, g1, o); *(u32x4*)P = o; } }
    __syncthreads();
    LAS unsigned short* T = (LAS unsigned short*)(lds + wave * 16640);
    for (int it = do_ab ? w : 3072 + gw; it < (do_ab ? 3072 : 3072 + 128); it += (do_ab ? W : NGW)) {
        bf16_t* base; int pitch;
        if (it < 3072) { const int tile = it / 12, hs = it % 12; const int col = hs < 8 ? 2048 + 128 * hs : 4096 + 128 * (hs - 8); base = proj + (size_t)(64 * tile) * 5120 + col; pitch = 5120; }
        else { const int r = it - 3072, tile = r >> 2, h = r & 3; base = mkv + (size_t)(64 * tile) * 1024 + 512 + 128 * h; pitch = 1024; }
        vt_tile(base, pitch, T, lane);
    }
    __syncthreads();
}
#undef POST_LOAD
__device__ __forceinline__ void mem_own_post(const Params& p, LAS unsigned char* lds, int pm, int pn) {
    const int tid = threadIdx.x, lane = tid & 63, wave = __builtin_amdgcn_readfirstlane(tid >> 6);
    bf16_t* mkv = (bf16_t*)(p.ws + WS_MKV);
    __builtin_amdgcn_fence(__ATOMIC_ACQUIRE, "agent");
    asm volatile("s_waitcnt vmcnt(0)" ::: "memory");
    __syncthreads();
    if (pn < 2) {
        const int go = (lane & 15) * 8;
        const f32x4 g0 = *(const f32x4*)(p.in[16] + go), g1 = *(const f32x4*)(p.in[16] + go + 4);
#pragma unroll 4
        for (int i = 0; i < 16; ++i) { bf16_t* P = mkv + (size_t)(256 * pm + 32 * wave + 2 * i + (lane >> 5)) * 1024 + 256 * pn + (lane & 31) * 8;
            u32x4 o; headnorm_r(*(const u32x4*)P, g0, g1, o); *(u32x4*)P = o; }
    } else {
        const int tile = 4 * pm + (wave >> 1), h = 2 * (pn - 2) + (wave & 1);
        vt_tile(mkv + (size_t)(64 * tile) * 1024 + 512 + 128 * h, 1024, (LAS unsigned short*)(lds + wave * 16640), lane);
    }
}


__device__ __forceinline__ void attn_phase(const Params& p, LAS unsigned char* lds, int rep) {
    const int wave = __builtin_amdgcn_readfirstlane(threadIdx.x >> 6);
    unsigned char* ws = p.ws;
    const bf16_t* proj = (const bf16_t*)(ws + WS_RH); const bf16_t* mkv = (const bf16_t*)(ws + WS_MKV);
    bf16_t* obuf = (bf16_t*)(ws + WS_RA);
    const float* logf_ = (const float*)(ws + WS_LOGF); const float* kmean = (const float*)(ws + WS_KMEAN);
    unsigned* ctr = (unsigned*)(ws + WS_CTR) + rep;
    LAS unsigned char* Kb = lds; LAS unsigned char* Vb = lds + 32768;
    LAS float* cs = (LAS float*)(lds + 69632); LAS float* tab = (LAS float*)(lds + 77824);
    LAS unsigned* selm = (LAS unsigned*)(lds + 78336); LAS int* misc = (LAS int*)(lds + 133632); LAS float* wtot = (LAS float*)(lds + 133632 + 64);
    const float NINF = -__builtin_inff();
    for (;;) {
        int tid = threadIdx.x; asm volatile("" : "+v"(tid));
        int lane = tid & 63;
        __syncthreads();
        if (tid == 0) misc[0] = (int)atomicAdd(ctr, 1u);
        __syncthreads();
        const int qi = __builtin_amdgcn_readfirstlane(misc[0]);
        int idx;
        if (DEFER_CONV) {
            if (qi >= 1024 + 592) break;
            if (qi < 256) idx = qi;
            else if (qi < 256 + 1184) { const int q2 = qi - 256;
                if (q2 & 1) { const int cblk = q2 >> 1; tr_run(p, (LAS float*)(lds + wave * 16640), lane, 1, 16 * cblk + 2 * wave, 16 * cblk + 2 * wave + 2, 1); continue; }
                idx = 256 + (q2 >> 1);
            } else idx = 848 + (qi - 1440);
        } else { idx = qi; if (idx >= 1024) break; }
        int type, b, h, qb;
        if (idx < 768) { const int lvl = idx / 96, r = idx % 96; qb = 7 - lvl; if (r < 64) { type = 0; b = r >> 3; h = r & 7; } else { type = 1; b = (r - 64) >> 2; h = (r - 64) & 3; } }
        else { const int r = idx - 768; type = 2; b = r >> 5; h = (r >> 3) & 3; qb = r & 7; }
        const bf16_t *Qp, *Kp, *Vp; int kpitch, nt, hg; size_t krow0;
        if (type == 0) { Qp = proj + 128 * h; Kp = proj + 1024 + 128 * h; Vp = proj + 2048 + 128 * h; kpitch = 5120; nt = 4 * (qb + 1); hg = h; krow0 = (size_t)b * 2048; }
        else if (type == 1) { Qp = proj + 3072 + 128 * h; Kp = proj + 3584 + 128 * h; Vp = proj + 4096 + 128 * h; kpitch = 5120; nt = 4 * (qb + 1); hg = 8 + h; krow0 = (size_t)b * 2048; }
        else { Qp = proj + 4608 + 128 * h; Kp = mkv + 128 * h; Vp = mkv + 512 + 128 * h; kpitch = 1024; nt = 4; hg = 12 + h; krow0 = (size_t)b * 256; }
        const int qrow0 = qb * 256 + wave * 32;
        const float Bt = ((const float*)(ws + WS_BND))[type];
        if (type == 0) {
            const float* lf = logf_ + (size_t)(b * 2048) * 8 + h;
            const float v0 = lf[(4 * tid + 0) * 8], v1 = lf[(4 * tid + 1) * 8], v2 = lf[(4 * tid + 2) * 8], v3 = lf[(4 * tid + 3) * 8];
            const float s1 = v0, s2 = s1 + v1, s3 = s2 + v2, s4 = s3 + v3;
            float tot = s4;
#pragma unroll
            for (int o = 1; o < 64; o <<= 1) { const float n = __shfl_up(tot, o); if (lane >= o) tot += n; }
            if (lane == 63) wtot[wave] = tot;
            __syncthreads();
            float basev = 0.f;
            for (int w = 0; w < wave; ++w) basev += wtot[w];
            const float excl = basev + tot - s4;
            cs[4 * tid + 0] = (excl + s1) * LOG2E; cs[4 * tid + 1] = (excl + s2) * LOG2E; cs[4 * tid + 2] = (excl + s3) * LOG2E; cs[4 * tid + 3] = (excl + s4) * LOG2E;
            __syncthreads();
        } else if (type == 1) {
            if (tid < 128) { const int n = tid; int bk = n; if (n >= 16) { bk = 16 + (int)(__logf((float)n * (1.0f / 16.0f)) / 2.0794415416798357f * 16.0f); bk = bk > 31 ? 31 : bk; }
                tab[tid] = p.in[22][bk * 4 + h] * LOG2E - Bt; }
            { const int q = tid >> 1, half = tid & 1; const bf16_t* qr = Qp + (size_t)(b * 2048 + qb * 256 + q) * 5120 + 64 * half;
              for (int j = 0; j < qb; ++j) {
                  const float* km = kmean + ((size_t)((b * 4 + h) * 8 + j)) * 128 + 64 * half; float a = 0.f;
#pragma unroll
                  for (int c8 = 0; c8 < 8; ++c8) { const u32x4 raw = *(const u32x4*)(qr + 8 * c8); const f32x4 k0 = *(const f32x4*)(km + 8 * c8), k1 = *(const f32x4*)(km + 8 * c8 + 4);
                      a += (bf_lo(raw.x) * k0[0] + bf_hi(raw.x) * k0[1]) + (bf_lo(raw.y) * k0[2] + bf_hi(raw.y) * k0[3]) + (bf_lo(raw.z) * k1[0] + bf_hi(raw.z) * k1[1]) + (bf_lo(raw.w) * k1[2] + bf_hi(raw.w) * k1[3]); }
                  a += __shfl_xor(a, 1);
                  if (half == 0) cs[q * 8 + j] = a;
              } }
            __syncthreads();
            if (tid < 256) { unsigned mask = 0u;
                for (int j = 0; j < qb; ++j) { const float gj = cs[tid * 8 + j]; int rank = 0;
                    for (int i = 0; i < qb; ++i) { const float gi = cs[tid * 8 + i]; rank += (gi > gj || (gi == gj && i < j)) ? 1 : 0; }
                    if (rank < 3) mask |= 1u << j; }
                selm[tid] = mask; }
            __syncthreads();
        }
        tid = threadIdx.x; asm volatile("" : "+v"(tid));
        lane = tid & 63;
        const int fr = lane & 15, g = lane >> 4;
        int kt0 = 0; float cqw = 0.f;
        if (type == 0) {
            const float cqf = __builtin_bit_cast(float, __builtin_amdgcn_readfirstlane(__builtin_bit_cast(int, cs[qb * 256])));
            while (kt0 < nt - 4 && cqf - __builtin_bit_cast(float, __builtin_amdgcn_readfirstlane(__builtin_bit_cast(int, cs[64 * kt0 + 63]))) < -160.0f) ++kt0;
            kt0 &= ~1;
            cqw = __builtin_bit_cast(float, __builtin_amdgcn_readfirstlane(__builtin_bit_cast(int, cs[qrow0])));
        }
        bf16x8 Qf[2][4];
#pragma unroll
        for (int sub = 0; sub < 2; ++sub)
#pragma unroll
            for (int ks = 0; ks < 4; ++ks) Qf[sub][ks] = *(const bf16x8*)(Qp + (size_t)(b * 2048 + qrow0 + 16 * sub + fr) * 5120 + 32 * ks + 8 * g);
        float cq0 = 0.f, cq1 = 0.f; unsigned sm0 = 0u, sm1 = 0u; float tab127 = 0.f;
        if (type == 0) { cq0 = cs[qrow0 + fr] - Bt; cq1 = cs[qrow0 + 16 + fr] - Bt; }
        if (type == 1) { sm0 = selm[wave * 32 + fr]; sm1 = selm[wave * 32 + 16 + fr]; tab127 = tab[127]; }
        f32x4 O[2][8];
#pragma unroll
        for (int sub = 0; sub < 2; ++sub)
#pragma unroll
            for (int db = 0; db < 8; ++db) O[sub][db] = (f32x4){0.f, 0.f, 0.f, 0.f};
        float l0 = 0.f, l1 = 0.f;
        const int sr0 = tid >> 4, scc = tid & 15;
        const unsigned kdst0 = (unsigned)(sr0 * 256 + ((scc ^ (sr0 & 15)) << 4)), kdst1 = kdst0 + 32 * 256;
        const unsigned vdst0 = (unsigned)((2 * sr0 + (scc >> 3)) * 128 + (((scc & 7) ^ (sr0 & 7)) << 4)), vdst1 = vdst0 + 64 * 128;
        u32x4 kr0, kr1, vr0, vr1;
#define ATT_LOAD(kt) do { const size_t rb = krow0 + (size_t)64 * (kt) + sr0; \
            kr0 = *(const u32x4*)(Kp + rb * kpitch + scc * 8); kr1 = *(const u32x4*)(Kp + (rb + 32) * kpitch + scc * 8); \
            vr0 = *(const u32x4*)(Vp + rb * kpitch + scc * 8); vr1 = *(const u32x4*)(Vp + (rb + 32) * kpitch + scc * 8); } while (0)
#define ATT_STORE(buf) do { *(LAS u32x4*)(Kb + (buf) * 16384 + kdst0) = kr0; *(LAS u32x4*)(Kb + (buf) * 16384 + kdst1) = kr1; \
            *(LAS u32x4*)(Vb + (buf) * 16384 + vdst0) = vr0; *(LAS u32x4*)(Vb + (buf) * 16384 + vdst1) = vr1; } while (0)
        ATT_LOAD(kt0); ATT_STORE(0);
        __syncthreads();
        for (int kt = kt0; kt < nt; ++kt) {
            const bool more = kt + 1 < nt;
            if (more) ATT_LOAD(kt + 1);
            const int k0 = 64 * kt;
            bool active = (type == 2) || (k0 <= qrow0 + 31);
            if (type == 0 && active) active = (cqw - __builtin_bit_cast(float, __builtin_amdgcn_readfirstlane(__builtin_bit_cast(int, cs[k0 + 63]))) >= -160.0f);
            if (active) {
                const LAS unsigned char* Kc = Kb + (kt & 1) * 16384; const LAS unsigned char* Vc = Vb + (kt & 1) * 16384;
                f32x4 S[4][2];
                const bool diag = (k0 + 63 > qrow0);
                const int blk = k0 >> 8; const bool ownblk = (blk == qb);
                if (type == 0) {
#pragma unroll
                    for (int kb = 0; kb < 4; ++kb) { const f32x4 ck = *(const LAS f32x4*)(cs + k0 + 16 * kb + 4 * g);
                        S[kb][0] = cq0 - ck; S[kb][1] = cq1 - ck; }
                } else if (type == 1) {
                    const bool nearb = (qrow0 - (k0 + 63) < 127);
                    if (nearb) {
#pragma unroll
                        for (int kb = 0; kb < 4; ++kb)
#pragma unroll
                            for (int sub = 0; sub < 2; ++sub)
#pragma unroll
                                for (int i = 0; i < 4; ++i) { int di = (qrow0 + 16 * sub + fr) - (k0 + 16 * kb + 4 * g + i); di = di < 0 ? 0 : di; di = di > 127 ? 127 : di; S[kb][sub][i] = tab[di]; }
                    } else {
#pragma unroll
                        for (int kb = 0; kb < 4; ++kb) { S[kb][0] = (f32x4){tab127, tab127, tab127, tab127}; S[kb][1] = S[kb][0]; }
                    }
                } else {
#pragma unroll
                    for (int kb = 0; kb < 4; ++kb) { S[kb][0] = (f32x4){-Bt, -Bt, -Bt, -Bt}; S[kb][1] = S[kb][0]; }
                }
                {
#define ATT_LDK(dst, kb) do { _Pragma("unroll") for (int _ks = 0; _ks < 4; ++_ks) dst[_ks] = *(const LAS bf16x8*)(Kc + (16 * (kb) + fr) * 256 + (((4 * _ks + g) ^ fr) << 4)); } while (0)
#define ATT_QK(src, kb) do { _Pragma("unroll") for (int _ks = 0; _ks < 4; ++_ks) { \
                        S[kb][0] = __builtin_amdgcn_mfma_f32_16x16x32_bf16(src[_ks], Qf[0][_ks], S[kb][0], 0, 0, 0); \
                        S[kb][1] = __builtin_amdgcn_mfma_f32_16x16x32_bf16(src[_ks], Qf[1][_ks], S[kb][1], 0, 0, 0); } } while (0)
                    bf16x8 kfa[4], kfb[4];
                    ATT_LDK(kfa, 0); ATT_LDK(kfb, 1);
                    __builtin_amdgcn_sched_barrier(0);
                    ATT_QK(kfa, 0);
                    __builtin_amdgcn_sched_barrier(0);
                    ATT_LDK(kfa, 2);
                    __builtin_amdgcn_sched_barrier(0);
                    ATT_QK(kfb, 1);
                    __builtin_amdgcn_sched_barrier(0);
                    ATT_LDK(kfb, 3);
                    __builtin_amdgcn_sched_barrier(0);
                    ATT_QK(kfa, 2);
                    __builtin_amdgcn_sched_barrier(0);
                    ATT_QK(kfb, 3);
                    __builtin_amdgcn_sched_barrier(0);
#undef ATT_LDK
#undef ATT_QK
                }
                if (type != 2 && ownblk && diag) {
#pragma unroll
                    for (int kb = 0; kb < 4; ++kb)
#pragma unroll
                        for (int sub = 0; sub < 2; ++sub)
#pragma unroll
                            for (int i = 0; i < 4; ++i) if (k0 + 16 * kb + 4 * g + i > qrow0 + 16 * sub + fr) S[kb][sub][i] = NINF;
                }
                if (type == 1 && !ownblk) {
                    const bool ok0 = ((sm0 >> blk) & 1u) != 0u, ok1 = ((sm1 >> blk) & 1u) != 0u;
#pragma unroll
                    for (int kb = 0; kb < 4; ++kb) { if (!ok0) S[kb][0] = (f32x4){NINF, NINF, NINF, NINF}; if (!ok1) S[kb][1] = (f32x4){NINF, NINF, NINF, NINF}; }
                }
                __builtin_amdgcn_sched_barrier(0);
                {
                    float rs0 = 0.f, rs1 = 0.f;
#pragma unroll
                    for (int kb = 0; kb < 4; ++kb)
#pragma unroll
                        for (int i = 0; i < 4; ++i) { const float p0 = __builtin_amdgcn_exp2f(S[kb][0][i]), p1 = __builtin_amdgcn_exp2f(S[kb][1][i]);
                            S[kb][0][i] = p0; S[kb][1][i] = p1; rs0 += p0; rs1 += p1; }
                    l0 += rs0; l1 += rs1;
                }
                {
                    bf16x8 Pf[2][2];
#pragma unroll
                    for (int kk = 0; kk < 2; ++kk)
#pragma unroll
                        for (int sub = 0; sub < 2; ++sub) { u32x4 w; w.x = pk2(S[2 * kk][sub][0], S[2 * kk][sub][1]); w.y = pk2(S[2 * kk][sub][2], S[2 * kk][sub][3]);
                            w.z = pk2(S[2 * kk + 1][sub][0], S[2 * kk + 1][sub][1]); w.w = pk2(S[2 * kk + 1][sub][2], S[2 * kk + 1][sub][3]); Pf[kk][sub] = __builtin_bit_cast(bf16x8, w); }
#define ATT_LDV(dst, dg) do { _Pragma("unroll") for (int _d = 0; _d < 2; ++_d) _Pragma("unroll") for (int _kk = 0; _kk < 2; ++_kk) \
                        dst[_d][_kk] = *(const LAS bf16x8*)(Vc + (16 * (2 * (dg) + _d) + fr) * 128 + (((4 * _kk + g) ^ (fr >> 1)) << 4)); } while (0)
#define ATT_PV(src, dg) do { _Pragma("unroll") for (int _d = 0; _d < 2; ++_d) _Pragma("unroll") for (int _kk = 0; _kk < 2; ++_kk) { \
                        O[0][2 * (dg) + _d] = __builtin_amdgcn_mfma_f32_16x16x32_bf16(src[_d][_kk], Pf[_kk][0], O[0][2 * (dg) + _d], 0, 0, 0); \
                        O[1][2 * (dg) + _d] = __builtin_amdgcn_mfma_f32_16x16x32_bf16(src[_d][_kk], Pf[_kk][1], O[1][2 * (dg) + _d], 0, 0, 0); } } while (0)
                    bf16x8 va[2][2], vb[2][2], vc[2][2];
                    ATT_LDV(va, 0); ATT_LDV(vb, 1);
                    __builtin_amdgcn_sched_barrier(0);
                    ATT_LDV(vc, 2);
                    ATT_PV(va, 0);
                    __builtin_amdgcn_sched_barrier(0);
                    ATT_LDV(va, 3);
                    ATT_PV(vb, 1);
                    __builtin_amdgcn_sched_barrier(0);
                    ATT_PV(vc, 2);
                    __builtin_amdgcn_sched_barrier(0);
                    ATT_PV(va, 3);
                    __builtin_amdgcn_sched_barrier(0);
#undef ATT_LDV
#undef ATT_PV
                }
            }
            if (more) ATT_STORE((kt + 1) & 1);
            __syncthreads();
        }
#undef ATT_LOAD
#undef ATT_STORE
#pragma unroll
        for (int sub = 0; sub < 2; ++sub) {
            float l = sub ? l1 : l0; l += __shfl_xor(l, 16); l += __shfl_xor(l, 32);
            const float inv = 1.0f / l;
            bf16_t* orow = obuf + (size_t)(b * 2048 + qrow0 + 16 * sub + fr) * 2048 + hg * 128 + 4 * g;
#pragma unroll
            for (int db = 0; db < 8; ++db) { const f32x4 v = O[sub][db] * inv; u32x2 w; w.x = pk2(v[0], v[1]); w.y = pk2(v[2], v[3]); *(u32x2*)(orow + 16 * db) = w; }
        }
    }
}

__global__ void __launch_bounds__(512, 2) fwd_mega(Params p) {
    extern __shared__ __attribute__((aligned(16))) unsigned char lds_raw[];
    LAS unsigned char* lds = (LAS unsigned char*)lds_raw;
    cg::grid_group grid = cg::this_grid();
    unsigned char* ws = p.ws;
    const int lo = p.ph_lo, hi = p.ph_hi, G = gridDim.x, c = blockIdx.x;
#define IN(k) (lo <= (k) && (k) < hi)
#define SEAM(k) do { if (IN(k) && IN((k) + 1)) xcd_barrier(xbar); } while (0)
    bf16_t* RA = (bf16_t*)(ws + WS_RA); bf16_t* RB = (bf16_t*)(ws + WS_RB); bf16_t* RH = (bf16_t*)(ws + WS_RH);
    volatile LAS unsigned* xst = (volatile LAS unsigned*)(lds + LDS_BYTES - 64);
    if (threadIdx.x < 4) xst[threadIdx.x] = 0u;
    __syncthreads();
    XcdBarrier xbar; xbar.bar = (unsigned*)(ws + WS_BAR); xbar.x = 0; xbar.st = xst;
    if (hi - lo > 1) xbar = xcd_barrier_post((unsigned*)(ws + WS_BAR), xst);
    if (lo < 0) grid.sync();
    if (IN(0)) { for (int rep = 0; rep < REP0; ++rep) { phase0(p, lds); __syncthreads(); } }
    SEAM(0);
    if (IN(1)) {
        pg8::Gemm gm{RA, (const bf16_t*)(ws + WS_W13_1), 16384, 11264, 2048}; pg8::StaticOrder S; S.init(16384, 11264, G, c);
        EpiSwiGLU E{RH, 5632, nullptr};
        for (int rep = 0; rep < REP1; ++rep) pg8::gemm_phase<EpiSwiGLU, pg8::StaticOrder, true, true>(lds, gm, S, E);
    }
    SEAM(1);
    if (IN(2)) {
        pg8::Gemm gm{RH, (const bf16_t*)(ws + WS_W2_1), 16384, 2048, 5632}; pg8::StaticOrder S; S.init(16384, 2048, G, c);
        EpiResid E{p.in[0], p.out, RA, (float*)(ws + WS_SS2), 0.5f, 2048};
        pg8::gemm_phase<EpiResid, pg8::StaticOrder, true, true>(lds, gm, S, E);
    }
    SEAM(2);
    if (IN(3)) {
        { pg8::Gemm gm{RA, (const bf16_t*)(ws + WS_WIN), 16384, 5120, 2048}; pg8::StaticOrder S; S.init(16384, 5120, G, c);
          EpiScale E{RH, 5120, (const float*)(ws + WS_SS2)};
          pg8::gemm_phase<EpiScale, pg8::StaticOrder, true, true>(lds, gm, S, E); }
    }
    SEAM(3);
    if (IN(4)) {
        const int cm = (c + 128) % G; const bool split = (G >= 64);
        if (cm < 32) { pg8::Gemm gm{(const bf16_t*)(ws + WS_MEMB), (const bf16_t*)(ws + WS_WMEM), 2048, 1024, 2048}; pg8::StaticOrder S; S.init(2048, 1024, G, cm);
          EpiScale E{(bf16_t*)(ws + WS_MKV), 1024, (const float*)(ws + WS_SSM)};
          pg8::gemm_phase<EpiScale, pg8::StaticOrder, true, true>(lds, gm, S, E);
          pg8::Unit u; if (S.next(0, u)) mem_own_post(p, lds, u.pm, u.pn); }
        if (!split || cm >= 32) post_phase(p, lds, split ? cm - 32 : c, split ? G - 32 : G, true, false);
    }
    SEAM(4);
    if (IN(4) && !IN(5) && IN(6)) xcd_barrier(xbar);
    if (IN(6)) { for (int rep = 0; rep < REP5; ++rep) attn_phase(p, lds, rep); }
    SEAM(6);
    if (IN(7)) {
        pg8::Gemm gm{RA, (const bf16_t*)(ws + WS_WOUT), 16384, 2048, 2048}; pg8::StaticOrder S; S.init(16384, 2048, G, c);
        EpiResid E{p.out, p.out, RB, (float*)(ws + WS_SS3), 1.0f, 2048};
        pg8::gemm_phase<EpiResid, pg8::StaticOrder, true, true>(lds, gm, S, E);
    }
    SEAM(7);
    if (IN(8)) {
        pg8::Gemm gm{RB, (const bf16_t*)(ws + WS_W13_2), 16384, 11264, 2048}; pg8::StaticOrder S; S.init(16384, 11264, G, c);
        EpiSwiGLU E{RH, 5632, (const float*)(ws + WS_SS3)};
        pg8::gemm_phase<EpiSwiGLU, pg8::StaticOrder, true, true>(lds, gm, S, E);
    }
    SEAM(8);
    if (IN(9)) {
        pg8::Gemm gm{RH, (const bf16_t*)(ws + WS_W2_2), 16384, 2048, 5632}; pg8::StaticOrder S; S.init(16384, 2048, G, c);
        EpiResid E{p.out, p.out, nullptr, nullptr, 0.5f, 2048};
        pg8::gemm_phase<EpiResid, pg8::StaticOrder, true, true>(lds, gm, S, E);
    }
#undef IN
#undef SEAM
}

extern "C" void kernel_launch(void* const* d_in, const int* in_sizes, int n_in, void* d_out, int out_size, void* d_ws, size_t ws_size, hipStream_t stream) {
    static int grid = 0;
    if (grid == 0) {
        if (n_in != 23 || out_size != 16384 * 2048 || ws_size < WS_END) { fprintf(stderr, "kernel_launch: unexpected shapes / workspace (n_in %d out %d ws %zu need %zu)\n", n_in, out_size, ws_size, (size_t)WS_END); grid = -1; return; }
        int dev = 0, cus = 0, per_cu = 0;
        if (hipGetDevice(&dev) != hipSuccess || hipDeviceGetAttribute(&cus, hipDeviceAttributeMultiprocessorCount, dev) != hipSuccess) { grid = -1; return; }
        if (hipFuncSetAttribute((const void*)fwd_mega, hipFuncAttributeMaxDynamicSharedMemorySize, LDS_BYTES) != hipSuccess) { fprintf(stderr, "kernel_launch: hipFuncSetAttribute failed\n"); grid = -1; return; }
        if (hipOccupancyMaxActiveBlocksPerMultiprocessor(&per_cu, (const void*)fwd_mega, 512, LDS_BYTES) != hipSuccess || per_cu < 1) { fprintf(stderr, "kernel_launch: occupancy query says %d\n", per_cu); }
        (void)hipGetLastError();
        grid = cus;
    }
    if (grid < 0) return;
    Params p{};
    for (int i = 0; i < 23; ++i) p.in[i] = (const float*)d_in[i];
    p.out = (float*)d_out; p.ws = (unsigned char*)d_ws;
#if ONE_LAUNCH
    p.ph_lo = 0; p.ph_hi = NPHASE;
    void* args[] = {&p};
    if (hipMemsetAsync((unsigned char*)d_ws + WS_BAR, 0, 16384, stream) != hipSuccess) { fprintf(stderr, "kernel_launch: memset of the barrier words failed\n"); return; }
    hipError_t e = hipLaunchCooperativeKernel((const void*)fwd_mega, dim3(grid), dim3(512), args, LDS_BYTES, stream);
    if (e != hipSuccess) fprintf(stderr, "cooperative launch failed: %s (grid %d)\n", hipGetErrorString(e), grid);
#else
    for (int k = 0; k < NPHASE; ++k) { p.ph_lo = k; p.ph_hi = k + 1; hipLaunchKernelGGL(fwd_mega, dim3(grid), dim3(512), LDS_BYTES, stream, p); }
#endif
}
```

```cpp
#include <hip/hip_runtime.h>
#include <hip/hip_cooperative_groups.h>
#include <cstdio>
namespace cg = cooperative_groups;
namespace pg8 {
#define PG8_LAS __attribute__((address_space(3)))
typedef unsigned short bf16_t;
typedef short bf16x8 __attribute__((ext_vector_type(8)));
typedef float f32x4 __attribute__((ext_vector_type(4)));
typedef unsigned u32x4 __attribute__((ext_vector_type(4)));
constexpr int BM = 256, BK = 64, HALF = 128, HTB = HALF * BK * 2  , STAGE_BYTES = 8 * HTB, NXCD = 8, WGM = 6;

__host__ __device__ __forceinline__ int lds_byte(int r, int c) { const int st = (r >> 4) * 2 + (c >> 5), rr = r & 15, cc = c & 31, ob = rr * 64 + cc * 2; return st * 1024 + (ob ^ (((ob >> 9) & 1) << 5)); }
__host__ __device__ __forceinline__ void stage_rc(int b, int& R, int& C) { const int st = b / 1024, sb = b % 1024, swz = sb ^ (((sb >> 9) & 1) << 5); R = (st >> 1) * 16 + swz / 64; C = (st & 1) * 32 + (swz % 64) / 2; }
__host__ __device__ __forceinline__ int perm32(int rho) { const int n = rho >> 4, i = rho & 15; return 8 * (i >> 2) + 4 * n + (i & 3); }

struct Unit { int pm, pn; };
struct Gemm { const bf16_t* A; const bf16_t* Bt; int M, N, K; };

struct StaticOrder {
    int nM, nN, nwg, G, c;
    __host__ __device__ void init(int M, int N, int G_, int c_) { nM = M / BM; nN = N / BM; nwg = nM * nN; G = G_; c = c_; }
    __host__ __device__ bool next(int i, Unit& u) const {
        const long L = (long)i * G + c; if (L >= nwg) return false;
        int wgid = (int)L; { const int q = nwg / NXCD, r = nwg % NXCD, xcd = wgid % NXCD, off = wgid / NXCD; wgid = (xcd < r ? xcd * (q + 1) : r * (q + 1) + (xcd - r) * q) + off; }
        const int nig = WGM * nN, gid = wgid / nig, fm = gid * WGM, gsz = (nM - fm) < WGM ? (nM - fm) : WGM;
        u.pm = fm + ((wgid % nig) % gsz); u.pn = (wgid % nig) / gsz; return true;
    }
    __device__ __forceinline__ void a_ready(const Unit&) const {}
    __device__ __forceinline__ void done(const Unit&) const {}
};
__device__ __forceinline__ unsigned cvt_pk_bf16(float lo, float hi) { unsigned r; asm volatile("v_cvt_pk_bf16_f32 %0, %1, %2" : "=v"(r) : "v"(lo), "v"(hi)); return r; }
typedef float f32x2 __attribute__((ext_vector_type(2)));
template <class Epi, class Sched, bool ALIGN_EPI = false, bool SP2 = false>
__device__ __forceinline__ void gemm_phase(PG8_LAS unsigned char* lds, const Gemm g, const Sched& S, const Epi& E) {
    const int tid = threadIdx.x, wid = __builtin_amdgcn_readfirstlane(tid >> 6), lane = tid & 63, wr = wid >> 2, wc = wid & 3, fr = lane & 15, fq = lane >> 4;
    const int K = g.K, nt = K / BK;
    unsigned voffA[2], voffB[2];
#pragma unroll
    for (int i = 0; i < 2; ++i) { int R, C; stage_rc(tid * 16 + i * 8192, R, C); const int Rb = Epi::PERM ? ((R & ~31) + perm32(R & 31)) : R;
        voffA[i] = (unsigned)(R * K + C) * 2u; voffB[i] = (unsigned)(Rb * K + C) * 2u; }
    const size_t kstep = (size_t)(BK * 2);
    const size_t hstep = (size_t)HALF * K * 2;
    const size_t tstep = 2 * hstep;
    const unsigned ldsw = (unsigned)wid * 1024u;
    const int aoff = lds_byte(wr * 64 + fr, fq * 8), boff = lds_byte(wc * 32 + fr, fq * 8);
#define PG8_SA(b, h) (((b) * 2 + (h)) * HTB)
#define PG8_SB(b, h) ((4 + (b) * 2 + (h)) * HTB)
#define PG8_STAGE(bufoff, gbase, voff) do { _Pragma("unroll") for (int _i = 0; _i < 2; ++_i) \
        __builtin_amdgcn_global_load_lds((const unsigned*)((const char*)(gbase) + (voff)[_i]), (PG8_LAS unsigned*)(lds + (bufoff) + ldsw + _i * 8192), 16, 0, 0); } while (0)
#define PG8_LDA(dst, b, h) do { _Pragma("unroll") for (int m = 0; m < 4; ++m) _Pragma("unroll") for (int k = 0; k < 2; ++k) dst[m][k] = *(const PG8_LAS bf16x8*)(lds + PG8_SA(b, h) + aoff + m * 2048 + k * 1024); } while (0)
#define PG8_LDB(dst, b, h) do { _Pragma("unroll") for (int n = 0; n < 2; ++n) _Pragma("unroll") for (int k = 0; k < 2; ++k) dst[n][k] = *(const PG8_LAS bf16x8*)(lds + PG8_SB(b, h) + boff + n * 2048 + k * 1024); } while (0)
#define PG8_MMA(ai, bj, At, Bt) do { __builtin_amdgcn_s_setprio(1); _Pragma("unroll") for (int m = 0; m < 4; ++m) _Pragma("unroll") for (int n = 0; n < 2; ++n) _Pragma("unroll") for (int k = 0; k < 2; ++k) \
        acc[ai][bj][m][n] = __builtin_amdgcn_mfma_f32_16x16x32_bf16(Bt[n][k], At[m][k], acc[ai][bj][m][n], 0, 0, 0); __builtin_amdgcn_s_setprio(0); } while (0)
#define PG8_WAIT_V(n) asm volatile("s_waitcnt vmcnt(" #n ")" ::: "memory")
#define PG8_WAIT_L(n) asm volatile("s_waitcnt lgkmcnt(" #n ")" ::: "memory")
#define PG8_BAR __builtin_amdgcn_s_barrier()
#define PG8_SCHED __builtin_amdgcn_sched_barrier(0)
    Unit cur, nxt; int ui = 0;
    if (!S.next(0, cur)) return;
    f32x4 acc[2][2][4][2];
#pragma unroll
    for (int a = 0; a < 2; ++a)
#pragma unroll
        for (int b = 0; b < 2; ++b)
#pragma unroll
            for (int m = 0; m < 4; ++m)
#pragma unroll
                for (int n = 0; n < 2; ++n) acc[a][b][m][n] = (f32x4){0.f, 0.f, 0.f, 0.f};
    bf16x8 At[4][2], B0[2][2], B1[2][2];
    const char* cA = (const char*)g.A + (size_t)cur.pm * tstep; const char* cB = (const char*)g.Bt + (size_t)cur.pn * tstep;
    S.a_ready(cur);
    if constexpr (SP2) {
        PG8_STAGE(PG8_SB(0, 0), cB, voffB); PG8_STAGE(PG8_SB(0, 1), cB + hstep, voffB); PG8_STAGE(PG8_SA(0, 0), cA, voffA); PG8_STAGE(PG8_SA(0, 1), cA + hstep, voffA);
        if (wr == 1) PG8_BAR;
        PG8_WAIT_V(2); PG8_BAR;
        PG8_STAGE(PG8_SB(1, 0), cB + kstep, voffB); PG8_STAGE(PG8_SA(1, 0), cA + kstep, voffA); PG8_STAGE(PG8_SB(1, 1), cB + hstep + kstep, voffB);
        PG8_WAIT_V(6); PG8_BAR;
    } else {
        PG8_STAGE(PG8_SB(0, 0), cB, voffB); PG8_STAGE(PG8_SA(0, 0), cA, voffA); PG8_STAGE(PG8_SB(0, 1), cB + hstep, voffB); PG8_STAGE(PG8_SA(0, 1), cA + hstep, voffA);
        if (wr == 1) PG8_BAR;
        PG8_WAIT_V(4); PG8_BAR;
        PG8_STAGE(PG8_SB(1, 0), cB + kstep, voffB); PG8_STAGE(PG8_SA(1, 0), cA + kstep, voffA); PG8_STAGE(PG8_SB(1, 1), cB + hstep + kstep, voffB);
        PG8_WAIT_V(6); PG8_BAR;
    }
    for (;;) {
        const bool has_next = S.next(ui + 1, nxt);
        const char* nA = has_next ? (const char*)g.A + (size_t)nxt.pm * tstep : cA; const char* nB = has_next ? (const char*)g.Bt + (size_t)nxt.pn * tstep : cB;
        for (int t = 0; t < nt; t += 2) {
            const bool last = (t == nt - 2);
            const char* a1 = cA + (size_t)(t + 1) * kstep;
            const char* a2 = last ? nA : cA + (size_t)(t + 2) * kstep; const char* b2 = last ? nB : cB + (size_t)(t + 2) * kstep;
            const char* a3 = a2 + kstep; const char* b3 = b2 + kstep;
            if (last && has_next) S.a_ready(nxt);
            if constexpr (SP2) {
            PG8_LDB(B0, 0, 0); PG8_LDB(B1, 0, 1); PG8_SCHED; PG8_LDA(At, 0, 0); PG8_STAGE(PG8_SA(1, 1), a1 + hstep, voffA);
            PG8_WAIT_V(8); PG8_WAIT_L(0); PG8_BAR; PG8_MMA(0, 0, At, B0); PG8_MMA(0, 1, At, B1); PG8_BAR; PG8_SCHED;
            PG8_LDA(At, 0, 1); PG8_STAGE(PG8_SB(0, 0), b2, voffB); PG8_STAGE(PG8_SB(0, 1), b2 + hstep, voffB); PG8_STAGE(PG8_SA(0, 0), a2, voffA);
            PG8_WAIT_V(8); PG8_WAIT_L(0); PG8_BAR; PG8_MMA(1, 0, At, B0); PG8_MMA(1, 1, At, B1); PG8_BAR; PG8_SCHED;
            PG8_LDB(B0, 1, 0); PG8_LDB(B1, 1, 1); PG8_SCHED; PG8_LDA(At, 1, 0); PG8_STAGE(PG8_SA(0, 1), a2 + hstep, voffA);
            PG8_WAIT_V(8); PG8_WAIT_L(0); PG8_BAR; PG8_MMA(0, 0, At, B0); PG8_MMA(0, 1, At, B1); PG8_BAR; PG8_SCHED;
            PG8_LDA(At, 1, 1); PG8_STAGE(PG8_SB(1, 0), b3, voffB); PG8_STAGE(PG8_SB(1, 1), b3 + hstep, voffB); PG8_STAGE(PG8_SA(1, 0), a3, voffA);
            PG8_WAIT_V(8); PG8_WAIT_L(0); PG8_BAR; PG8_MMA(1, 0, At, B0); PG8_MMA(1, 1, At, B1); PG8_BAR; PG8_SCHED;
            } else {
            PG8_LDB(B0, 0, 0); PG8_SCHED; PG8_LDA(At, 0, 0); PG8_STAGE(PG8_SA(1, 1), a1 + hstep, voffA);
            PG8_WAIT_L(8); PG8_BAR; PG8_WAIT_L(0); PG8_MMA(0, 0, At, B0); PG8_BAR; PG8_SCHED;
            PG8_LDB(B1, 0, 1); PG8_STAGE(PG8_SB(0, 0), b2, voffB);
            PG8_BAR; PG8_WAIT_L(0); PG8_MMA(0, 1, At, B1); PG8_BAR;
            PG8_LDA(At, 0, 1); PG8_STAGE(PG8_SA(0, 0), a2, voffA);
            PG8_BAR; PG8_WAIT_L(0); PG8_MMA(1, 0, At, B0); PG8_BAR; PG8_SCHED;
            PG8_STAGE(PG8_SB(0, 1), b2 + hstep, voffB);
            PG8_WAIT_V(6); PG8_BAR; PG8_MMA(1, 1, At, B1); PG8_BAR;
            PG8_LDB(B0, 1, 0); PG8_SCHED; PG8_LDA(At, 1, 0); PG8_STAGE(PG8_SA(0, 1), a2 + hstep, voffA);
            PG8_WAIT_L(8); PG8_BAR; PG8_WAIT_L(0); PG8_MMA(0, 0, At, B0); PG8_BAR; PG8_SCHED;
            PG8_LDB(B1, 1, 1); PG8_STAGE(PG8_SB(1, 0), b3, voffB);
            PG8_BAR; PG8_WAIT_L(0); PG8_MMA(0, 1, At, B1); PG8_BAR;
            PG8_LDA(At, 1, 1); PG8_STAGE(PG8_SA(1, 0), a3, voffA);
            PG8_BAR; PG8_WAIT_L(0); PG8_MMA(1, 0, At, B0); PG8_BAR; PG8_SCHED;
            PG8_STAGE(PG8_SB(1, 1), b3 + hstep, voffB);
            PG8_WAIT_V(6); PG8_BAR; PG8_MMA(1, 1, At, B1); PG8_BAR;
            }
        }
        if constexpr (ALIGN_EPI) { if (wr == 0) PG8_BAR; }
        if constexpr (!Epi::AFTER_DRAIN) { E(acc, cur, wr, wc, fr, fq); S.done(cur); }
        if (!has_next) break;
#pragma unroll
        for (int a = 0; a < 2; ++a)
#pragma unroll
            for (int b = 0; b < 2; ++b)
#pragma unroll
                for (int m = 0; m < 4; ++m)
#pragma unroll
                    for (int n = 0; n < 2; ++n) acc[a][b][m][n] = (f32x4){0.f, 0.f, 0.f, 0.f};
        cur = nxt; cA = nA; cB = nB; ++ui;
        if constexpr (ALIGN_EPI) { if (wr == 1) PG8_BAR; }
    }
    PG8_WAIT_V(0);
    if constexpr (!ALIGN_EPI) { if (wr == 0) PG8_BAR; }
    PG8_BAR;
    if constexpr (Epi::AFTER_DRAIN) { E.fused(acc, cur, wr, wc, fr, fq, lds, wid, lane); S.done(cur); }
#undef PG8_SA
#undef PG8_SB
#undef PG8_STAGE
#undef PG8_LDA
#undef PG8_LDB
#undef PG8_MMA
#undef PG8_WAIT_V
#undef PG8_WAIT_L
#undef PG8_BAR
#undef PG8_SCHED
}
}
#define LAS __attribute__((address_space(3)))
#define XB_TMO      128
#define XB_XCNT(j)  (256  + 64 * (j))
#define XB_XSUB(j)  (1280 + 64 * (j))
#define XB_XGEN(j)  (2304 + 64 * (j))
#define XB_TOP      3328
#define XB_TOPGEN   3392
#define XCD_BAR_WORDS 3456
#define XB_SPIN_CAP (1u << 18)

__device__ __forceinline__ unsigned xb_ld(unsigned* p)              { return __hip_atomic_load(p, __ATOMIC_RELAXED, __HIP_MEMORY_SCOPE_AGENT); }
__device__ __forceinline__ unsigned xb_add(unsigned* p, unsigned v) { return __hip_atomic_fetch_add(p, v, __ATOMIC_RELAXED, __HIP_MEMORY_SCOPE_AGENT); }
__device__ __forceinline__ unsigned xb_xcc_id() { return (unsigned)__builtin_amdgcn_s_getreg((3 << 11) | 20) & 0xFu; }
#define XB_SPIN(cond, bar) do { unsigned _sp = 0; while (cond) { __builtin_amdgcn_s_sleep(1); \
    if ((++_sp & 255u) == 0u) { if (xb_ld(&(bar)[XB_TMO])) break; if (_sp > XB_SPIN_CAP) { atomicAdd(&(bar)[XB_TMO], 1u); break; } } } } while (0)

struct XcdBarrier {
    unsigned* bar; unsigned x;
    volatile LAS unsigned* st;
};

__device__ __forceinline__ XcdBarrier xcd_barrier_post(unsigned* bar, volatile LAS unsigned* st) {
    XcdBarrier b; b.bar = bar; b.x = xb_xcc_id(); b.st = st;
    if (threadIdx.x == 0) (void)xb_add(&bar[XB_XCNT(b.x)], 1u);
    return b;
}
__device__ __forceinline__ void xcd_barrier_complete(unsigned* bar, unsigned x, unsigned& nloc, unsigned& nx) {
    const unsigned G = gridDim.x * gridDim.y * gridDim.z;
    unsigned sum, cnt, mine, sp = 0u;
    for (;;) {
        sum = 0u; cnt = 0u; mine = 0u;
#pragma unroll
        for (unsigned j = 0; j < 16; ++j) { const unsigned c = xb_ld(&bar[XB_XCNT(j)]); sum += c; cnt += (c > 0u) ? 1u : 0u; mine = (j == x) ? c : mine; }
        if (sum == G) break;
        __builtin_amdgcn_s_sleep(1);
        if ((++sp & 255u) == 0u) { if (xb_ld(&bar[XB_TMO])) break; if (sp > XB_SPIN_CAP) { atomicAdd(&bar[XB_TMO], 1u); break; } }
    }
    nloc = mine > 0u ? mine : 1u; nx = cnt > 0u ? cnt : 1u;
}

__device__ __forceinline__ void xcd_barrier(const XcdBarrier& b) {
    asm volatile("s_waitcnt vmcnt(0)" ::: "memory");
    __syncthreads();
    if (threadIdx.x == 0) {
        unsigned* bar = b.bar;
        __builtin_amdgcn_s_waitcnt(0);
        unsigned nloc = b.st[0], nx = b.st[1];
        if (nloc == 0u) { xcd_barrier_complete(bar, b.x, nloc, nx); b.st[0] = nloc; b.st[1] = nx; }
        const unsigned old = xb_add(&bar[XB_XSUB(b.x)], 1u);
        const unsigned gen = old / nloc;
        if (old + 1u == (gen + 1u) * nloc) {
            __builtin_amdgcn_fence(__ATOMIC_RELEASE, "agent");
            asm volatile("s_waitcnt vmcnt(0)" ::: "memory");
            const unsigned og = xb_add(&bar[XB_TOP], 1u);
            const unsigned tg = og / nx;
            if (og + 1u == (tg + 1u) * nx) xb_add(&bar[XB_TOPGEN], 1u);
            else XB_SPIN(xb_ld(&bar[XB_TOPGEN]) == tg, bar);
            __builtin_amdgcn_fence(__ATOMIC_ACQUIRE, "agent");
            xb_add(&bar[XB_XGEN(b.x)], 1u);
            asm volatile("s_waitcnt vmcnt(0)" ::: "memory");
        } else {
            XB_SPIN(xb_ld(&bar[XB_XGEN(b.x)]) == gen, bar);
            __builtin_amdgcn_fence(__ATOMIC_ACQUIRE, "agent");
            asm volatile("s_waitcnt vmcnt(0)" ::: "memory");
        }
    }
    __syncthreads();
}


using pg8::bf16_t; using pg8::bf16x8; using pg8::f32x4; using pg8::u32x4;

typedef unsigned u32x2 __attribute__((ext_vector_type(2)));

#ifndef ONE_LAUNCH
#define ONE_LAUNCH 1
#endif
constexpr int NPHASE = 10;
#ifndef DEFER_CONV
#define DEFER_CONV 1
#endif
#ifndef REP0
#define REP0 1
#endif
#ifndef REP1
#define REP1 1
#endif
#ifndef REP5
#define REP5 1
#endif
constexpr float EPS = 1e-6f;
constexpr float LOG2E = 1.4426950408889634f;
constexpr int LDS_BYTES = 139264;

constexpr size_t SZ_W13 = (size_t)11264 * 2048 * 2, SZ_W2 = (size_t)2048 * 5632 * 2;
constexpr size_t WS_W13_1 = 0;
constexpr size_t WS_W2_1 = WS_W13_1 + SZ_W13;
constexpr size_t WS_W13_2 = WS_W2_1 + SZ_W2;
constexpr size_t WS_W2_2 = WS_W13_2 + SZ_W13;
constexpr size_t WS_WIN = WS_W2_2 + SZ_W2;
constexpr size_t WS_WOUT = WS_WIN + (size_t)5120 * 2048 * 2;
constexpr size_t WS_WMEM = WS_WOUT + (size_t)2048 * 2048 * 2;
constexpr size_t WS_WFF = WS_WMEM + (size_t)1024 * 2048 * 2;
constexpr size_t WS_RA = WS_WFF + 65536;
constexpr size_t WS_RB = WS_RA + (size_t)16384 * 2048 * 2;
constexpr size_t WS_RH = WS_RB + (size_t)16384 * 2048 * 2;
constexpr size_t WS_MEMB = WS_RH + (size_t)16384 * 5632 * 2;
constexpr size_t WS_MKV = WS_MEMB + (size_t)2048 * 2048 * 2;
constexpr size_t WS_SS1 = WS_MKV + (size_t)2048 * 1024 * 2;
constexpr size_t WS_SS2 = WS_SS1 + 65536;
constexpr size_t WS_SS3 = WS_SS2 + 65536;
constexpr size_t WS_SSM = WS_SS3 + 65536;
constexpr size_t WS_LOGF = WS_SSM + 8192;
constexpr size_t WS_KMEAN = WS_LOGF + 524288;
constexpr size_t WS_CTR = WS_KMEAN + 131072;
constexpr size_t WS_BAR = WS_CTR + 256;
constexpr size_t WS_BND = WS_BAR + 16384;
constexpr size_t WS_END = WS_BND + 256;

struct Params { const float* in[23]; float* out; unsigned char* ws; int ph_lo, ph_hi; };

__device__ __forceinline__ float wave_sum(float v) {
#pragma unroll
    for (int o = 1; o < 64; o <<= 1) v += __shfl_xor(v, o);
    return v;
}
__device__ __forceinline__ unsigned pk2(float a, float b) { return pg8::cvt_pk_bf16(a, b); }
__device__ __forceinline__ float bf_lo(unsigned u) { return __uint_as_float(u << 16); }
__device__ __forceinline__ float bf_hi(unsigned u) { return __uint_as_float(u & 0xffff0000u); }
__device__ __forceinline__ float rstd_of(float ss, float invn) { return 1.0f / sqrtf(ss * invn + EPS); }

struct EpiSwiGLU {
    static constexpr bool PERM = true, AFTER_DRAIN = false;
    bf16_t* H; int ldh; const float* ss;
    __device__ __forceinline__ void operator()(const f32x4 (&acc)[2][2][4][2], const pg8::Unit& u, int wr, int wc, int fr, int fq) const {
        const int row0 = u.pm * 256 + wr * 64 + fr, col0 = u.pn * 128 + wc * 32 + 8 * fq;
#pragma unroll
        for (int ai = 0; ai < 2; ++ai)
#pragma unroll
            for (int m = 0; m < 4; ++m) {
                const int row = row0 + ai * 128 + m * 16;
                const float rs = ss ? rstd_of(ss[row], 1.0f / 2048.0f) : 1.0f;
                u32x4 w;
                unsigned wv[4];
#pragma unroll
                for (int n = 0; n < 2; ++n) {
                    const f32x4 gt = acc[ai][0][m][n] * rs, up = acc[ai][1][m][n] * rs;
                    float hv[4];
#pragma unroll
                    for (int j = 0; j < 4; ++j) { const float e = __builtin_amdgcn_exp2f(-gt[j] * LOG2E); hv[j] = gt[j] * __builtin_amdgcn_rcpf(1.0f + e) * up[j]; }
                    wv[2 * n] = pk2(hv[0], hv[1]); wv[2 * n + 1] = pk2(hv[2], hv[3]);
                }
                w.x = wv[0]; w.y = wv[1]; w.z = wv[2]; w.w = wv[3];
                *(u32x4*)(H + (size_t)row * ldh + col0) = w;
            }
    }
};
struct EpiResid {
    static constexpr bool PERM = true, AFTER_DRAIN = false;
    const float* base; float* out; bf16_t* ob; float* ssq; float alpha; int ld;
    __device__ __forceinline__ void operator()(const f32x4 (&acc)[2][2][4][2], const pg8::Unit& u, int wr, int wc, int fr, int fq) const {
        const int row0 = u.pm * 256 + wr * 64 + fr, col0 = u.pn * 256 + wc * 32 + 8 * fq;
#pragma unroll
        for (int ai = 0; ai < 2; ++ai) {
            f32x4 r0[4][2], r1[4][2];
#pragma unroll
            for (int m = 0; m < 4; ++m)
#pragma unroll
                for (int bj = 0; bj < 2; ++bj) { const size_t off = (size_t)(row0 + ai * 128 + m * 16) * ld + col0 + bj * 128;
                    r0[m][bj] = __builtin_nontemporal_load((const f32x4*)(base + off)); r1[m][bj] = __builtin_nontemporal_load((const f32x4*)(base + off + 4)); }
#pragma unroll
            for (int m = 0; m < 4; ++m) {
                const int row = row0 + ai * 128 + m * 16; const size_t off = (size_t)row * ld + col0;
                float s = 0.f;
#pragma unroll
                for (int bj = 0; bj < 2; ++bj) {
                    const f32x4 v0 = r0[m][bj] + acc[ai][bj][m][0] * alpha, v1 = r1[m][bj] + acc[ai][bj][m][1] * alpha;
                    __builtin_nontemporal_store(v0, (f32x4*)(out + off + bj * 128)); __builtin_nontemporal_store(v1, (f32x4*)(out + off + bj * 128 + 4));
                    if (ob) { u32x4 w; w.x = pk2(v0[0], v0[1]); w.y = pk2(v0[2], v0[3]); w.z = pk2(v1[0], v1[1]); w.w = pk2(v1[2], v1[3]); *(u32x4*)(ob + off + bj * 128) = w; }
                    s += (v0[0] * v0[0] + v0[1] * v0[1]) + (v0[2] * v0[2] + v0[3] * v0[3]) + (v1[0] * v1[0] + v1[1] * v1[1]) + (v1[2] * v1[2] + v1[3] * v1[3]);
                }
                if (ssq) { s += __shfl_xor(s, 16); s += __shfl_xor(s, 32); if (fq == 0) atomicAdd(ssq + row, s); }
            }
            asm volatile("" ::: "memory");
        }
    }
};
struct EpiScale {
    static constexpr bool PERM = true, AFTER_DRAIN = false;
    bf16_t* O; int ldc; const float* ss;
    __device__ __forceinline__ void operator()(const f32x4 (&acc)[2][2][4][2], const pg8::Unit& u, int wr, int wc, int fr, int fq) const {
        const int row0 = u.pm * 256 + wr * 64 + fr, col0 = u.pn * 256 + wc * 32 + 8 * fq;
#pragma unroll
        for (int ai = 0; ai < 2; ++ai)
#pragma unroll
            for (int m = 0; m < 4; ++m) {
                const int row = row0 + ai * 128 + m * 16;
                const float rs = rstd_of(ss[row], 1.0f / 2048.0f);
#pragma unroll
                for (int bj = 0; bj < 2; ++bj) {
                    const f32x4 v0 = acc[ai][bj][m][0] * rs, v1 = acc[ai][bj][m][1] * rs;
                    u32x4 w; w.x = pk2(v0[0], v0[1]); w.y = pk2(v0[2], v0[3]); w.z = pk2(v1[0], v1[1]); w.w = pk2(v1[2], v1[3]);
                    *(u32x4*)(O + (size_t)row * ldc + col0 + bj * 128) = w;
                }
            }
    }
};

struct TrItem { const float* W; const float* gain; bf16_t* WT; int ldw, col0, K, drow0, k0; };
__device__ __forceinline__ void tr_decode(const Params& p, int it, TrItem& t) {
    unsigned char* ws = p.ws;
    constexpr int I_W1 = 32 * 88, I_W2 = 88 * 32, I_INA = 32 * 48, I_INB = 32 * 32, I_OUT = 32 * 32;
    int r = it;
    if (r < 4 * I_W1) { const int which = r / I_W1; r -= which * I_W1; const int kb = r / 88, nb = r % 88, n0 = 64 * nb;
        const float *w0 = p.in[3], *w1 = p.in[4], *w2 = p.in[19], *w3 = p.in[20], *ga = p.in[2], *gb = p.in[18];
        asm volatile("" : "+s"(w0), "+s"(w1), "+s"(w2), "+s"(w3), "+s"(ga), "+s"(gb));
        t.W = which == 0 ? w0 : which == 1 ? w1 : which == 2 ? w2 : w3; t.gain = which < 2 ? ga : gb;
        t.WT = (bf16_t*)(ws + (which < 2 ? WS_W13_1 : WS_W13_2)); t.ldw = 5632; t.col0 = n0; t.K = 2048; t.drow0 = 256 * (n0 >> 7) + 128 * (which & 1) + (n0 & 127); t.k0 = 64 * kb; return; }
    r -= 4 * I_W1;
    if (r < 2 * I_W2) { const int which = r / I_W2; r -= which * I_W2; const int kb = r / 32, nb = r % 32;
        const float *w0 = p.in[5], *w1 = p.in[21]; asm volatile("" : "+s"(w0), "+s"(w1));
        t.W = which ? w1 : w0; t.gain = nullptr; t.WT = (bf16_t*)(ws + (which ? WS_W2_2 : WS_W2_1)); t.ldw = 2048; t.col0 = 64 * nb; t.K = 5632; t.drow0 = 64 * nb; t.k0 = 64 * kb; return; }
    r -= 2 * I_W2;
    if (r < I_INA) { const int kb = r / 48, nb = r % 48; t.W = p.in[8]; t.gain = p.in[6]; t.WT = (bf16_t*)(ws + WS_WIN); t.ldw = 5128; t.col0 = 64 * nb; t.K = 2048; t.drow0 = 64 * nb; t.k0 = 64 * kb; return; }
    r -= I_INA;
    if (r < I_INB) { const int kb = r / 32, nb = r % 32; t.W = p.in[8]; t.gain = p.in[6]; t.WT = (bf16_t*)(ws + WS_WIN); t.ldw = 5128; t.col0 = 3080 + 64 * nb; t.K = 2048; t.drow0 = 3072 + 64 * nb; t.k0 = 64 * kb; return; }
    r -= I_INB;
    if (r < I_OUT) { const int kb = r / 32, nb = r % 32; t.W = p.in[17]; t.gain = nullptr; t.WT = (bf16_t*)(ws + WS_WOUT); t.ldw = 2048; t.col0 = 64 * nb; t.K = 2048; t.drow0 = 64 * nb; t.k0 = 64 * kb; return; }
    r -= I_OUT;
    { const int kb = r / 16, nb = r % 16; t.W = p.in[10]; t.gain = p.in[7]; t.WT = (bf16_t*)(ws + WS_WMEM); t.ldw = 1024; t.col0 = 64 * nb; t.K = 2048; t.drow0 = 64 * nb; t.k0 = 64 * kb; }
}
#define TR_LOAD(t) do { const float* _b = (t).W + (size_t)((t).k0 + (lane >> 4)) * (t).ldw + (t).col0 + (lane & 15) * 4; \
        _Pragma("unroll") for (int _i = 0; _i < 16; ++_i) v[_i] = __builtin_nontemporal_load((const f32x4*)(_b + (size_t)(4 * _i) * (t).ldw)); } while (0)
constexpr int TR_N0 = 11520, TR_N1 = 9472;
__device__ __forceinline__ int tr_id(int set, int j) {
    if (set == 0) return j < 5632 ? j : j < 8448 ? 11264 + (j - 5632) : j < 11008 ? 16896 + (j - 8448) : 20480 + (j - 11008);
    return j < 5632 ? 5632 + j : j < 8448 ? 14080 + (j - 5632) : 19456 + (j - 8448);
}
__device__ __forceinline__ void tr_run(const Params& p, LAS float* scr, int lane, int set, int j0, int jend, int stride) {
    f32x4 v[16]; TrItem cur, nxt;
    int it = j0;
    if (it < jend) { tr_decode(p, tr_id(set, it), cur); TR_LOAD(cur); }
    while (it < jend) {
        const int kq = lane >> 4, n4 = (lane & 15) * 4;
#pragma unroll
        for (int i = 0; i < 16; ++i) { const int k = 4 * i + kq;
            scr[(n4 + 0) * 65 + k] = v[i][0]; scr[(n4 + 1) * 65 + k] = v[i][1]; scr[(n4 + 2) * 65 + k] = v[i][2]; scr[(n4 + 3) * 65 + k] = v[i][3]; }
        const int itn = it + stride;
        if (itn < jend) { tr_decode(p, tr_id(set, itn), nxt); TR_LOAD(nxt); }
        asm volatile("s_waitcnt lgkmcnt(0)" ::: "memory");
        const int c = lane & 7;
        f32x4 g0 = {1.f, 1.f, 1.f, 1.f}, g1 = {1.f, 1.f, 1.f, 1.f};
        if (cur.gain) { g0 = *(const f32x4*)(cur.gain + cur.k0 + 8 * c); g1 = *(const f32x4*)(cur.gain + cur.k0 + 8 * c + 4); }
#pragma unroll
        for (int j = 0; j < 8; ++j) { const int n = (lane >> 3) + 8 * j; const LAS float* s = scr + n * 65 + 8 * c;
            u32x4 o; o.x = pk2(s[0] * g0[0], s[1] * g0[1]); o.y = pk2(s[2] * g0[2], s[3] * g0[3]); o.z = pk2(s[4] * g1[0], s[5] * g1[1]); o.w = pk2(s[6] * g1[2], s[7] * g1[3]);
            *(u32x4*)(cur.WT + (size_t)(cur.drow0 + n) * cur.K + cur.k0 + 8 * c) = o; }
        asm volatile("s_waitcnt lgkmcnt(0)" ::: "memory");
        cur = nxt; it = itn;
    }
}
__device__ __forceinline__ void phase0(const Params& p, LAS unsigned char* lds) {
    const int tid = threadIdx.x, lane = tid & 63, wave = __builtin_amdgcn_readfirstlane(tid >> 6);
    const int gw = blockIdx.x * 8 + wave, NGW = gridDim.x * 8;
    LAS float* scr = (LAS float*)(lds + wave * 16640);
    unsigned char* ws = p.ws;
    tr_run(p, scr, lane, DEFER_CONV ? 0 : 0, gw, TR_N0, NGW);
    if (!DEFER_CONV) tr_run(p, scr, lane, 1, gw, TR_N1, NGW);
    for (int m2 = gw; m2 < (16384 + 2048) / 2; m2 += NGW) {
        const int m = 2 * m2; const bool ismem = m >= 16384; const int r = ismem ? m - 16384 : m;
        const float *px = p.in[0], *pm = p.in[1]; asm volatile("" : "+s"(px), "+s"(pm));
        const f32x4* src = (const f32x4*)((ismem ? pm : px) + (size_t)r * 2048);
        u32x2* dst = (u32x2*)((bf16_t*)(ws + (ismem ? WS_MEMB : WS_RA)) + (size_t)r * 2048);
        f32x4 a[8], bq[8];
#pragma unroll
        for (int j = 0; j < 8; ++j) { a[j] = __builtin_nontemporal_load(src + lane + 64 * j); bq[j] = __builtin_nontemporal_load(src + 512 + lane + 64 * j); }
        float s0 = 0.f, s1 = 0.f;
#pragma unroll
        for (int j = 0; j < 8; ++j) { const f32x4 x = a[j], y = bq[j];
            s0 += (x[0] * x[0] + x[1] * x[1]) + (x[2] * x[2] + x[3] * x[3]); s1 += (y[0] * y[0] + y[1] * y[1]) + (y[2] * y[2] + y[3] * y[3]); }
        s0 = wave_sum(s0); s1 = wave_sum(s1);
        const float r0 = ismem ? 1.0f : rstd_of(s0, 1.0f / 2048.0f), r1 = ismem ? 1.0f : rstd_of(s1, 1.0f / 2048.0f);
#pragma unroll
        for (int j = 0; j < 8; ++j) { const f32x4 x = a[j] * r0, y = bq[j] * r1;
            u32x2 o; o.x = pk2(x[0], x[1]); o.y = pk2(x[2], x[3]); dst[lane + 64 * j] = o;
            u32x2 q; q.x = pk2(y[0], y[1]); q.y = pk2(y[2], y[3]); dst[512 + lane + 64 * j] = q; }
        if (lane == 0 && ismem) { float* so = (float*)(ws + WS_SSM); so[r] = s0; so[r + 1] = s1; }
    }
    const int gt = blockIdx.x * 512 + tid, NGT = gridDim.x * 512;
    for (int i = gt; i < 16384; i += NGT) { ((float*)(ws + WS_SS2))[i] = 0.f; ((float*)(ws + WS_SS3))[i] = 0.f;
        const int h = i >> 11, k = i & 2047; ((float*)(ws + WS_WFF))[i] = p.in[6][k] * p.in[8][(size_t)k * 5128 + 3072 + h]; }
    for (int i = gt; i < 32768; i += NGT) ((float*)(ws + WS_KMEAN))[i] = 0.f;
    if (gt < 8) ((unsigned*)(ws + WS_CTR))[gt] = 0u;
    if (blockIdx.x == 0 && wave < 3) {
        const float* gq = wave == 0 ? p.in[11] : wave == 1 ? p.in[13] : p.in[15]; const float* gk = wave == 0 ? p.in[12] : wave == 1 ? p.in[14] : p.in[16];
        float mq = fmaxf(fabsf(gq[lane]), fabsf(gq[lane + 64])), mk = fmaxf(fabsf(gk[lane]), fabsf(gk[lane + 64])), mb = fmaxf(fabsf(p.in[22][lane]), fabsf(p.in[22][lane + 64]));
#pragma unroll
        for (int o = 1; o < 64; o <<= 1) { mq = fmaxf(mq, __shfl_xor(mq, o)); mk = fmaxf(mk, __shfl_xor(mk, o)); mb = fmaxf(mb, __shfl_xor(mb, o)); }
        if (lane == 0) ((float*)(ws + WS_BND))[wave] = 128.0f * 0.08838834764831845f * LOG2E * mq * mk * 1.02f + (wave == 1 ? mb * LOG2E : 0.f);
    }
}

struct F8 { f32x4 a, b; };
__device__ __forceinline__ F8 headnorm_r(const u32x4 raw, const f32x4 g0, const f32x4 g1, u32x4& packed) {
    f32x4 a = {bf_lo(raw.x), bf_hi(raw.x), bf_lo(raw.y), bf_hi(raw.y)}, b = {bf_lo(raw.z), bf_hi(raw.z), bf_lo(raw.w), bf_hi(raw.w)};
    float s = (a[0] * a[0] + a[1] * a[1]) + (a[2] * a[2] + a[3] * a[3]) + (b[0] * b[0] + b[1] * b[1]) + (b[2] * b[2] + b[3] * b[3]);
    s += __shfl_xor(s, 1); s += __shfl_xor(s, 2); s += __shfl_xor(s, 4); s += __shfl_xor(s, 8);
    const float r = rstd_of(s, 1.0f / 128.0f);
    a = a * r * g0; b = b * r * g1;
    packed.x = pk2(a[0], a[1]); packed.y = pk2(a[2], a[3]); packed.z = pk2(b[0], b[1]); packed.w = pk2(b[2], b[3]);
    F8 res; res.a = a; res.b = b; return res;
}
__device__ __forceinline__ void vt_tile(bf16_t* base, int pitch, LAS unsigned short* T, int lane) {
    u32x4 v[16];
#pragma unroll
    for (int i = 0; i < 16; ++i) { const int c = lane + 64 * i, r = c >> 4, cc = c & 15; v[i] = *(const u32x4*)(base + (size_t)r * pitch + cc * 8); }
#pragma unroll
    for (int i = 0; i < 16; ++i) { const int c = lane + 64 * i, r = c >> 4, cc = c & 15;
        LAS unsigned* w = (LAS unsigned*)(T + r * 130 + cc * 8);
        w[0] = v[i].x; w[1] = v[i].y; w[2] = v[i].z; w[3] = v[i].w; }
    asm volatile("s_waitcnt lgkmcnt(0)" ::: "memory");
#pragma unroll
    for (int i = 0; i < 16; ++i) { const int c = lane + 64 * i, r = c >> 4, cc = c & 15, d = 2 * r + (cc >> 3), k0 = 8 * (cc & 7);
        const int kc = k0 >> 3, kbase = 32 * (kc >> 2) + 4 * (kc & 3);
        const LAS unsigned short* s = T + kbase * 130 + d;
        u32x4 o;
        o.x = (unsigned)s[0 * 130] | ((unsigned)s[1 * 130] << 16); o.y = (unsigned)s[2 * 130] | ((unsigned)s[3 * 130] << 16);
        o.z = (unsigned)s[16 * 130] | ((unsigned)s[17 * 130] << 16); o.w = (unsigned)s[18 * 130] | ((unsigned)s[19 * 130] << 16);
        *(u32x4*)(base + (size_t)r * pitch + cc * 8) = o; }
    asm volatile("s_waitcnt lgkmcnt(0)" ::: "memory");
}
struct PostRow { u32x4 c0, c1, c2, c3, c6, c7, c9; u32x2 x[8]; };
#define POST_LOAD(R, row) do { const bf16_t* _P = proj + (size_t)(row) * 5120 + lane * 8; const bf16_t* _X = x1b + (size_t)(row) * 2048 + lane * 4; \
        R.c0 = *(const u32x4*)(_P); R.c1 = *(const u32x4*)(_P + 512); R.c2 = *(const u32x4*)(_P + 1024); R.c3 = *(const u32x4*)(_P + 1536); \
        R.c6 = *(const u32x4*)(_P + 3072); R.c7 = *(const u32x4*)(_P + 3584); R.c9 = *(const u32x4*)(_P + 4608); \
        _Pragma("unroll") for (int _j = 0; _j < 8; ++_j) R.x[_j] = __builtin_nontemporal_load((const u32x2*)(_X + 256 * _j)); } while (0)
__device__ __forceinline__ void post_phase(const Params& p, LAS unsigned char* lds, int rb, int nb, bool do_ab, bool do_c) {
    const int tid = threadIdx.x, lane = tid & 63, wave = __builtin_amdgcn_readfirstlane(tid >> 6);
    const int gw = blockIdx.x * 8 + wave, NGW = gridDim.x * 8;
    const int w = rb * 8 + wave, W = nb * 8;
    unsigned char* ws = p.ws;
    bf16_t* proj = (bf16_t*)(ws + WS_RH); bf16_t* mkv = (bf16_t*)(ws + WS_MKV);
    const bf16_t* x1b = (const bf16_t*)(ws + WS_RA);
    const float* ss2 = (const float*)(ws + WS_SS2); const float* wff = (const float*)(ws + WS_WFF);
    float* logf_ = (float*)(ws + WS_LOGF); float* kmean = (float*)(ws + WS_KMEAN);
    LAS float* wl = (LAS float*)lds;
    if (do_ab) {
#pragma unroll
    for (int i = 0; i < 8; ++i) *(LAS f32x4*)(wl + (tid + 512 * i) * 4) = *(const f32x4*)(wff + (tid + 512 * i) * 4);
    }
    __syncthreads();
    const int go = (lane & 15) * 8;
    const float QSC = 0.08838834764831845f * LOG2E;
    const f32x4 gfq0 = *(const f32x4*)(p.in[11] + go) * QSC, gfq1 = *(const f32x4*)(p.in[11] + go + 4) * QSC, gfk0 = *(const f32x4*)(p.in[12] + go), gfk1 = *(const f32x4*)(p.in[12] + go + 4);
    const f32x4 gbq0 = *(const f32x4*)(p.in[13] + go) * QSC, gbq1 = *(const f32x4*)(p.in[13] + go + 4) * QSC, gbk0 = *(const f32x4*)(p.in[14] + go), gbk1 = *(const f32x4*)(p.in[14] + go + 4);
    const f32x4 gcq0 = *(const f32x4*)(p.in[15] + go) * QSC, gcq1 = *(const f32x4*)(p.in[15] + go + 4) * QSC;
    if (do_ab) {
        const int r0 = (int)(((long long)w * 16384) / W), r1 = (int)(((long long)(w + 1) * 16384) / W);
        f32x4 ka = {0.f, 0.f, 0.f, 0.f}, kb = {0.f, 0.f, 0.f, 0.f};
        PostRow cur, nxt;
        if (r0 < r1) POST_LOAD(cur, r0);
        for (int row = r0; row < r1; ++row) {
            if (row + 1 < r1) POST_LOAD(nxt, row + 1);
            bf16_t* P = proj + (size_t)row * 5120 + lane * 8;
            u32x4 o;
            headnorm_r(cur.c0, gfq0, gfq1, o); *(u32x4*)(P) = o;
            headnorm_r(cur.c1, gfq0, gfq1, o); *(u32x4*)(P + 512) = o;
            headnorm_r(cur.c2, gfk0, gfk1, o); *(u32x4*)(P + 1024) = o;
            headnorm_r(cur.c3, gfk0, gfk1, o); *(u32x4*)(P + 1536) = o;
            headnorm_r(cur.c6, gbq0, gbq1, o); *(u32x4*)(P + 3072) = o;
            { const F8 kk = headnorm_r(cur.c7, gbk0, gbk1, o); *(u32x4*)(P + 3584) = o; ka += kk.a; kb += kk.b; }
            headnorm_r(cur.c9, gcq0, gcq1, o); *(u32x4*)(P + 4608) = o;
            float d0 = 0.f, d1 = 0.f, d2 = 0.f, d3 = 0.f, d4 = 0.f, d5 = 0.f, d6 = 0.f, d7 = 0.f;
#pragma unroll
            for (int j = 0; j < 8; ++j) {
                const f32x4 xa = {bf_lo(cur.x[j].x), bf_hi(cur.x[j].x), bf_lo(cur.x[j].y), bf_hi(cur.x[j].y)};
                const LAS float* wp = wl + 256 * j + 4 * lane;
#define FF_DOT(H, D) { const f32x4 w0 = *(const LAS f32x4*)(wp + (H) * 2048); D += (xa[0] * w0[0] + xa[1] * w0[1]) + (xa[2] * w0[2] + xa[3] * w0[3]); }
                FF_DOT(0, d0) FF_DOT(1, d1) FF_DOT(2, d2) FF_DOT(3, d3) FF_DOT(4, d4) FF_DOT(5, d5) FF_DOT(6, d6) FF_DOT(7, d7)
#undef FF_DOT
            }
            d0 = wave_sum(d0); d1 = wave_sum(d1); d2 = wave_sum(d2); d3 = wave_sum(d3); d4 = wave_sum(d4); d5 = wave_sum(d5); d6 = wave_sum(d6); d7 = wave_sum(d7);
            if (lane < 8) {
                const float dv = lane == 0 ? d0 : lane == 1 ? d1 : lane == 2 ? d2 : lane == 3 ? d3 : lane == 4 ? d4 : lane == 5 ? d5 : lane == 6 ? d6 : d7;
                const float z = dv * rstd_of(ss2[row], 1.0f / 2048.0f) + p.in[9][lane];
                logf_[(size_t)row * 8 + lane] = fminf(z, 0.f) - log1pf(__expf(-fabsf(z)));
            }
            cur = nxt;
            if ((row & 255) == 255 || row + 1 == r1) {
                const int b = row >> 11, blk = (row & 2047) >> 8, h = lane >> 4;
                float* km = kmean + ((size_t)((b * 4 + h) * 8 + blk)) * 128 + (lane & 15) * 8;
                const float sc = 1.0f / 256.0f;
                atomicAdd(km + 0, ka[0] * sc); atomicAdd(km + 1, ka[1] * sc); atomicAdd(km + 2, ka[2] * sc); atomicAdd(km + 3, ka[3] * sc);
                atomicAdd(km + 4, kb[0] * sc); atomicAdd(km + 5, kb[1] * sc); atomicAdd(km + 6, kb[2] * sc); atomicAdd(km + 7, kb[3] * sc);
                ka = (f32x4){0.f, 0.f, 0.f, 0.f}; kb = (f32x4){0.f, 0.f, 0.f, 0.f};
            }
        }
    }
    if (do_c) { const f32x4 g0 = *(const f32x4*)(p.in[16] + go), g1 = *(const f32x4*)(p.in[16] + go + 4);
      for (int row = gw; row < 2048; row += NGW) { bf16_t* P = mkv + (size_t)row * 1024 + lane * 8; u32x4 o; headnorm_r(*(const u32x4*)P, g0, g1, o); *(u32x4*)P = o; } }
    __syncthreads();
    LAS unsigned short* T = (LAS unsigned short*)(lds + wave * 16640);
    for (int it = do_ab ? w : 3072 + gw; it < (do_ab ? 3072 : 3072 + 128); it += (do_ab ? W : NGW)) {
        bf16_t* base; int pitch;
        if (it < 3072) { const int tile = it / 12, hs = it % 12; const int col = hs < 8 ? 2048 + 128 * hs : 4096 + 128 * (hs - 8); base = proj + (size_t)(64 * tile) * 5120 + col; pitch = 5120; }
        else { const int r = it - 3072, tile = r >> 2, h = r & 3; base = mkv + (size_t)(64 * tile) * 1024 + 512 + 128 * h; pitch = 1024; }
        vt_tile(base, pitch, T, lane);
    }
    __syncthreads();
}
#undef POST_LOAD
__device__ __forceinline__ void mem_own_post(const Params& p, LAS unsigned char* lds, int pm, int pn) {
    const int tid = threadIdx.x, lane = tid & 63, wave = __builtin_amdgcn_readfirstlane(tid >> 6);
    bf16_t* mkv = (bf16_t*)(p.ws + WS_MKV);
    __builtin_amdgcn_fence(__ATOMIC_ACQUIRE, "agent");
    asm volatile("s_waitcnt vmcnt(0)" ::: "memory");
    __syncthreads();
    if (pn < 2) {
        const int go = (lane & 15) * 8;
        const f32x4 g0 = *(const f32x4*)(p.in[16] + go), g1 = *(const f32x4*)(p.in[16] + go + 4);
#pragma unroll 4
        for (int i = 0; i < 16; ++i) { bf16_t* P = mkv + (size_t)(256 * pm + 32 * wave + 2 * i + (lane >> 5)) * 1024 + 256 * pn + (lane & 31) * 8;
            u32x4 o; headnorm_r(*(const u32x4*)P, g0, g1, o); *(u32x4*)P = o; }
    } else {
        const int tile = 4 * pm + (wave >> 1), h = 2 * (pn - 2) + (wave & 1);
        vt_tile(mkv + (size_t)(64 * tile) * 1024 + 512 + 128 * h, 1024, (LAS unsigned short*)(lds + wave * 16640), lane);
    }
}


__device__ __forceinline__ void attn_phase(const Params& p, LAS unsigned char* lds, int rep) {
    const int wave = __builtin_amdgcn_readfirstlane(threadIdx.x >> 6);
    unsigned char* ws = p.ws;
    const bf16_t* proj = (const bf16_t*)(ws + WS_RH); const bf16_t* mkv = (const bf16_t*)(ws + WS_MKV);
    bf16_t* obuf = (bf16_t*)(ws + WS_RA);
    const float* logf_ = (const float*)(ws + WS_LOGF); const float* kmean = (const float*)(ws + WS_KMEAN);
    unsigned* ctr = (unsigned*)(ws + WS_CTR) + rep;
    LAS unsigned char* Kb = lds; LAS unsigned char* Vb = lds + 32768;
    LAS float* cs = (LAS float*)(lds + 69632); LAS float* tab = (LAS float*)(lds + 77824);
    LAS unsigned* selm = (LAS unsigned*)(lds + 78336); LAS int* misc = (LAS int*)(lds + 133632); LAS float* wtot = (LAS float*)(lds + 133632 + 64);
    const float NINF = -__builtin_inff();
    for (;;) {
        int tid = threadIdx.x; asm volatile("" : "+v"(tid));
        int lane = tid & 63;
        __syncthreads();
        if (tid == 0) misc[0] = (int)atomicAdd(ctr, 1u);
        __syncthreads();
        const int qi = __builtin_amdgcn_readfirstlane(misc[0]);
        int idx;
        if (DEFER_CONV) {
            if (qi >= 1024 + 592) break;
            if (qi < 256) idx = qi;
            else if (qi < 256 + 1184) { const int q2 = qi - 256;
                if (q2 & 1) { const int cblk = q2 >> 1; tr_run(p, (LAS float*)(lds + wave * 16640), lane, 1, 16 * cblk + 2 * wave, 16 * cblk + 2 * wave + 2, 1); continue; }
                idx = 256 + (q2 >> 1);
            } else idx = 848 + (qi - 1440);
        } else { idx = qi; if (idx >= 1024) break; }
        int type, b, h, qb;
        if (idx < 768) { const int lvl = idx / 96, r = idx % 96; qb = 7 - lvl; if (r < 32) { type = 1; b = r >> 2; h = r & 3; } else { type = 0; b = (r - 32) >> 3; h = (r - 32) & 7; } }
        else { const int r = idx - 768; type = 2; b = r >> 5; h = (r >> 3) & 3; qb = r & 7; }
        const bf16_t *Qp, *Kp, *Vp; int kpitch, nt, hg; size_t krow0;
        if (type == 0) { Qp = proj + 128 * h; Kp = proj + 1024 + 128 * h; Vp = proj + 2048 + 128 * h; kpitch = 5120; nt = 4 * (qb + 1); hg = h; krow0 = (size_t)b * 2048; }
        else if (type == 1) { Qp = proj + 3072 + 128 * h; Kp = proj + 3584 + 128 * h; Vp = proj + 4096 + 128 * h; kpitch = 5120; nt = 4 * (qb + 1); hg = 8 + h; krow0 = (size_t)b * 2048; }
        else { Qp = proj + 4608 + 128 * h; Kp = mkv + 128 * h; Vp = mkv + 512 + 128 * h; kpitch = 1024; nt = 4; hg = 12 + h; krow0 = (size_t)b * 256; }
        const int qrow0 = qb * 256 + wave * 32;
        const float Bt = ((const float*)(ws + WS_BND))[type];
        if (type == 0) {
            const float* lf = logf_ + (size_t)(b * 2048) * 8 + h;
            const float v0 = lf[(4 * tid + 0) * 8], v1 = lf[(4 * tid + 1) * 8], v2 = lf[(4 * tid + 2) * 8], v3 = lf[(4 * tid + 3) * 8];
            const float s1 = v0, s2 = s1 + v1, s3 = s2 + v2, s4 = s3 + v3;
            float tot = s4;
#pragma unroll
            for (int o = 1; o < 64; o <<= 1) { const float n = __shfl_up(tot, o); if (lane >= o) tot += n; }
            if (lane == 63) wtot[wave] = tot;
            __syncthreads();
            float basev = 0.f;
            for (int w = 0; w < wave; ++w) basev += wtot[w];
            const float excl = basev + tot - s4;
            cs[4 * tid + 0] = (excl + s1) * LOG2E; cs[4 * tid + 1] = (excl + s2) * LOG2E; cs[4 * tid + 2] = (excl + s3) * LOG2E; cs[4 * tid + 3] = (excl + s4) * LOG2E;
            __syncthreads();
        } else if (type == 1) {
            if (tid < 128) { const int n = tid; int bk = n; if (n >= 16) { bk = 16 + (int)(__logf((float)n * (1.0f / 16.0f)) / 2.0794415416798357f * 16.0f); bk = bk > 31 ? 31 : bk; }
                tab[tid] = p.in[22][bk * 4 + h] * LOG2E - Bt; }
            { const int q = tid >> 1, half = tid & 1; const bf16_t* qr = Qp + (size_t)(b * 2048 + qb * 256 + q) * 5120 + 64 * half;
              for (int j = 0; j < qb; ++j) {
                  const float* km = kmean + ((size_t)((b * 4 + h) * 8 + j)) * 128 + 64 * half; float a = 0.f;
#pragma unroll
                  for (int c8 = 0; c8 < 8; ++c8) { const u32x4 raw = *(const u32x4*)(qr + 8 * c8); const f32x4 k0 = *(const f32x4*)(km + 8 * c8), k1 = *(const f32x4*)(km + 8 * c8 + 4);
                      a += (bf_lo(raw.x) * k0[0] + bf_hi(raw.x) * k0[1]) + (bf_lo(raw.y) * k0[2] + bf_hi(raw.y) * k0[3]) + (bf_lo(raw.z) * k1[0] + bf_hi(raw.z) * k1[1]) + (bf_lo(raw.w) * k1[2] + bf_hi(raw.w) * k1[3]); }
                  a += __shfl_xor(a, 1);
                  if (half == 0) cs[q * 8 + j] = a;
              } }
            __syncthreads();
            if (tid < 256) { unsigned mask = 0u;
                for (int j = 0; j < qb; ++j) { const float gj = cs[tid * 8 + j]; int rank = 0;
                    for (int i = 0; i < qb; ++i) { const float gi = cs[tid * 8 + i]; rank += (gi > gj || (gi == gj && i < j)) ? 1 : 0; }
                    if (rank < 3) mask |= 1u << j; }
                selm[tid] = mask; }
            __syncthreads();
        }
        tid = threadIdx.x; asm volatile("" : "+v"(tid));
        lane = tid & 63;
        const int fr = lane & 15, g = lane >> 4;
        int kt0 = 0; float cqw = 0.f;
        if (type == 0) {
            const float cqf = __builtin_bit_cast(float, __builtin_amdgcn_readfirstlane(__builtin_bit_cast(int, cs[qb * 256])));
            while (kt0 < nt - 4 && cqf - __builtin_bit_cast(float, __builtin_amdgcn_readfirstlane(__builtin_bit_cast(int, cs[64 * kt0 + 63]))) < -160.0f) ++kt0;
            cqw = __builtin_bit_cast(float, __builtin_amdgcn_readfirstlane(__builtin_bit_cast(int, cs[qrow0])));
        }
        bf16x8 Qf[2][4];
#pragma unroll
        for (int sub = 0; sub < 2; ++sub)
#pragma unroll
            for (int ks = 0; ks < 4; ++ks) Qf[sub][ks] = *(const bf16x8*)(Qp + (size_t)(b * 2048 + qrow0 + 16 * sub + fr) * 5120 + 32 * ks + 8 * g);
        float cq0 = 0.f, cq1 = 0.f; unsigned sm0 = 0u, sm1 = 0u; float tab127 = 0.f;
        if (type == 0) { cq0 = cs[qrow0 + fr] - Bt; cq1 = cs[qrow0 + 16 + fr] - Bt; }
        if (type == 1) { sm0 = selm[wave * 32 + fr]; sm1 = selm[wave * 32 + 16 + fr]; tab127 = tab[127]; }
        f32x4 O[2][8];
#pragma unroll
        for (int sub = 0; sub < 2; ++sub)
#pragma unroll
            for (int db = 0; db < 8; ++db) O[sub][db] = (f32x4){0.f, 0.f, 0.f, 0.f};
        float l0 = 0.f, l1 = 0.f;
        const int sr0 = tid >> 4, scc = tid & 15;
        const unsigned kdst0 = (unsigned)(sr0 * 256 + ((scc ^ (sr0 & 15)) << 4)), kdst1 = kdst0 + 32 * 256;
        const unsigned vdst0 = (unsigned)((2 * sr0 + (scc >> 3)) * 128 + (((scc & 7) ^ (sr0 & 7)) << 4)), vdst1 = vdst0 + 64 * 128;
        u32x4 kr0, kr1, vr0, vr1;
#define ATT_LOAD(kt) do { const size_t rb = krow0 + (size_t)64 * (kt) + sr0; \
            kr0 = *(const u32x4*)(Kp + rb * kpitch + scc * 8); kr1 = *(const u32x4*)(Kp + (rb + 32) * kpitch + scc * 8); \
            vr0 = *(const u32x4*)(Vp + rb * kpitch + scc * 8); vr1 = *(const u32x4*)(Vp + (rb + 32) * kpitch + scc * 8); } while (0)
#define ATT_STORE(buf) do { *(LAS u32x4*)(Kb + (buf) * 16384 + kdst0) = kr0; *(LAS u32x4*)(Kb + (buf) * 16384 + kdst1) = kr1; \
            *(LAS u32x4*)(Vb + (buf) * 16384 + vdst0) = vr0; *(LAS u32x4*)(Vb + (buf) * 16384 + vdst1) = vr1; } while (0)
        ATT_LOAD(kt0); ATT_STORE(0);
        __syncthreads();
        for (int kt = kt0; kt < nt; ++kt) {
            const bool more = kt + 1 < nt;
            if (more) ATT_LOAD(kt + 1);
            const int k0 = 64 * kt;
            bool active = (type == 2) || (k0 <= qrow0 + 31);
            if (type == 0 && active) active = (cqw - __builtin_bit_cast(float, __builtin_amdgcn_readfirstlane(__builtin_bit_cast(int, cs[k0 + 63]))) >= -160.0f);
            if (active) {
                const LAS unsigned char* Kc = Kb + ((kt - kt0) & 1) * 16384; const LAS unsigned char* Vc = Vb + ((kt - kt0) & 1) * 16384;
                f32x4 S[4][2];
                const bool diag = (k0 + 63 > qrow0);
                const int blk = k0 >> 8; const bool ownblk = (blk == qb);
                if (type == 0) {
#pragma unroll
                    for (int kb = 0; kb < 4; ++kb) { const f32x4 ck = *(const LAS f32x4*)(cs + k0 + 16 * kb + 4 * g);
                        S[kb][0] = cq0 - ck; S[kb][1] = cq1 - ck; }
                } else if (type == 1) {
                    const bool nearb = (qrow0 - (k0 + 63) < 127);
                    if (nearb) {
#pragma unroll
                        for (int kb = 0; kb < 4; ++kb)
#pragma unroll
                            for (int sub = 0; sub < 2; ++sub)
#pragma unroll
                                for (int i = 0; i < 4; ++i) { int di = (qrow0 + 16 * sub + fr) - (k0 + 16 * kb + 4 * g + i); di = di < 0 ? 0 : di; di = di > 127 ? 127 : di; S[kb][sub][i] = tab[di]; }
                    } else {
#pragma unroll
                        for (int kb = 0; kb < 4; ++kb) { S[kb][0] = (f32x4){tab127, tab127, tab127, tab127}; S[kb][1] = S[kb][0]; }
                    }
                } else {
#pragma unroll
                    for (int kb = 0; kb < 4; ++kb) { S[kb][0] = (f32x4){-Bt, -Bt, -Bt, -Bt}; S[kb][1] = S[kb][0]; }
                }
                {
#define ATT_LDK(dst, kb) do { _Pragma("unroll") for (int _ks = 0; _ks < 4; ++_ks) dst[_ks] = *(const LAS bf16x8*)(Kc + (16 * (kb) + fr) * 256 + (((4 * _ks + g) ^ fr) << 4)); } while (0)
#define ATT_QK(src, kb) do { _Pragma("unroll") for (int _ks = 0; _ks < 4; ++_ks) { \
                        S[kb][0] = __builtin_amdgcn_mfma_f32_16x16x32_bf16(src[_ks], Qf[0][_ks], S[kb][0], 0, 0, 0); \
                        S[kb][1] = __builtin_amdgcn_mfma_f32_16x16x32_bf16(src[_ks], Qf[1][_ks], S[kb][1], 0, 0, 0); } } while (0)
                    bf16x8 kfa[4], kfb[4];
                    ATT_LDK(kfa, 0); ATT_LDK(kfb, 1);
                    __builtin_amdgcn_sched_barrier(0);
                    ATT_QK(kfa, 0);
                    __builtin_amdgcn_sched_barrier(0);
                    ATT_LDK(kfa, 2);
                    __builtin_amdgcn_sched_barrier(0);
                    ATT_QK(kfb, 1);
                    __builtin_amdgcn_sched_barrier(0);
                    ATT_LDK(kfb, 3);
                    __builtin_amdgcn_sched_barrier(0);
                    ATT_QK(kfa, 2);
                    __builtin_amdgcn_sched_barrier(0);
                    ATT_QK(kfb, 3);
                    __builtin_amdgcn_sched_barrier(0);
#undef ATT_LDK
#undef ATT_QK
                }
                if (type != 2 && ownblk && diag) {
#pragma unroll
                    for (int kb = 0; kb < 4; ++kb)
#pragma unroll
                        for (int sub = 0; sub < 2; ++sub)
#pragma unroll
                            for (int i = 0; i < 4; ++i) if (k0 + 16 * kb + 4 * g + i > qrow0 + 16 * sub + fr) S[kb][sub][i] = NINF;
                }
                if (type == 1 && !ownblk) {
                    const bool ok0 = ((sm0 >> blk) & 1u) != 0u, ok1 = ((sm1 >> blk) & 1u) != 0u;
#pragma unroll
                    for (int kb = 0; kb < 4; ++kb) { if (!ok0) S[kb][0] = (f32x4){NINF, NINF, NINF, NINF}; if (!ok1) S[kb][1] = (f32x4){NINF, NINF, NINF, NINF}; }
                }
                __builtin_amdgcn_sched_barrier(0);
                {
                    float rs0 = 0.f, rs1 = 0.f;
#pragma unroll
                    for (int kb = 0; kb < 4; ++kb)
#pragma unroll
                        for (int i = 0; i < 4; ++i) { const float p0 = __builtin_amdgcn_exp2f(S[kb][0][i]), p1 = __builtin_amdgcn_exp2f(S[kb][1][i]);
                            S[kb][0][i] = p0; S[kb][1][i] = p1; rs0 += p0; rs1 += p1; }
                    l0 += rs0; l1 += rs1;
                }
                {
                    bf16x8 Pf[2][2];
#pragma unroll
                    for (int kk = 0; kk < 2; ++kk)
#pragma unroll
                        for (int sub = 0; sub < 2; ++sub) { u32x4 w; w.x = pk2(S[2 * kk][sub][0], S[2 * kk][sub][1]); w.y = pk2(S[2 * kk][sub][2], S[2 * kk][sub][3]);
                            w.z = pk2(S[2 * kk + 1][sub][0], S[2 * kk + 1][sub][1]); w.w = pk2(S[2 * kk + 1][sub][2], S[2 * kk + 1][sub][3]); Pf[kk][sub] = __builtin_bit_cast(bf16x8, w); }
#define ATT_LDV(dst, dg) do { _Pragma("unroll") for (int _d = 0; _d < 2; ++_d) _Pragma("unroll") for (int _kk = 0; _kk < 2; ++_kk) \
                        dst[_d][_kk] = *(const LAS bf16x8*)(Vc + (16 * (2 * (dg) + _d) + fr) * 128 + (((4 * _kk + g) ^ (fr >> 1)) << 4)); } while (0)
#define ATT_PV(src, dg) do { _Pragma("unroll") for (int _d = 0; _d < 2; ++_d) _Pragma("unroll") for (int _kk = 0; _kk < 2; ++_kk) { \
                        O[0][2 * (dg) + _d] = __builtin_amdgcn_mfma_f32_16x16x32_bf16(src[_d][_kk], Pf[_kk][0], O[0][2 * (dg) + _d], 0, 0, 0); \
                        O[1][2 * (dg) + _d] = __builtin_amdgcn_mfma_f32_16x16x32_bf16(src[_d][_kk], Pf[_kk][1], O[1][2 * (dg) + _d], 0, 0, 0); } } while (0)
                    bf16x8 va[2][2], vb[2][2], vc[2][2];
                    ATT_LDV(va, 0); ATT_LDV(vb, 1);
                    __builtin_amdgcn_sched_barrier(0);
                    ATT_LDV(vc, 2);
                    ATT_PV(va, 0);
                    __builtin_amdgcn_sched_barrier(0);
                    ATT_LDV(va, 3);
                    ATT_PV(vb, 1);
                    __builtin_amdgcn_sched_barrier(0);
                    ATT_PV(vc, 2);
                    __builtin_amdgcn_sched_barrier(0);
                    ATT_PV(va, 3);
                    __builtin_amdgcn_sched_barrier(0);
#undef ATT_LDV
#undef ATT_PV
                }
            }
            if (more) ATT_STORE((kt + 1 - kt0) & 1);
            __syncthreads();
        }
#undef ATT_LOAD
#undef ATT_STORE
#pragma unroll
        for (int sub = 0; sub < 2; ++sub) {
            float l = sub ? l1 : l0; l += __shfl_xor(l, 16); l += __shfl_xor(l, 32);
            const float inv = 1.0f / l;
            bf16_t* orow = obuf + (size_t)(b * 2048 + qrow0 + 16 * sub + fr) * 2048 + hg * 128 + 4 * g;
#pragma unroll
            for (int db = 0; db < 8; ++db) { const f32x4 v = O[sub][db] * inv; u32x2 w; w.x = pk2(v[0], v[1]); w.y = pk2(v[2], v[3]); *(u32x2*)(orow + 16 * db) = w; }
        }
    }
}

__global__ void __launch_bounds__(512, 2) fwd_mega(Params p) {
    extern __shared__ __attribute__((aligned(16))) unsigned char lds_raw[];
    LAS unsigned char* lds = (LAS unsigned char*)lds_raw;
    cg::grid_group grid = cg::this_grid();
    unsigned char* ws = p.ws;
    const int lo = p.ph_lo, hi = p.ph_hi, G = gridDim.x, c = blockIdx.x;
#define IN(k) (lo <= (k) && (k) < hi)
#define SEAM(k) do { if (IN(k) && IN((k) + 1)) xcd_barrier(xbar); } while (0)
    bf16_t* RA = (bf16_t*)(ws + WS_RA); bf16_t* RB = (bf16_t*)(ws + WS_RB); bf16_t* RH = (bf16_t*)(ws + WS_RH);
    volatile LAS unsigned* xst = (volatile LAS unsigned*)(lds + LDS_BYTES - 64);
    if (threadIdx.x < 4) xst[threadIdx.x] = 0u;
    __syncthreads();
    XcdBarrier xbar; xbar.bar = (unsigned*)(ws + WS_BAR); xbar.x = 0; xbar.st = xst;
    if (hi - lo > 1) xbar = xcd_barrier_post((unsigned*)(ws + WS_BAR), xst);
    if (lo < 0) grid.sync();
    if (IN(0)) { for (int rep = 0; rep < REP0; ++rep) { phase0(p, lds); __syncthreads(); } }
    SEAM(0);
    if (IN(1)) {
        pg8::Gemm gm{RA, (const bf16_t*)(ws + WS_W13_1), 16384, 11264, 2048}; pg8::StaticOrder S; S.init(16384, 11264, G, c);
        EpiSwiGLU E{RH, 5632, nullptr};
        for (int rep = 0; rep < REP1; ++rep) pg8::gemm_phase<EpiSwiGLU, pg8::StaticOrder, true, true>(lds, gm, S, E);
    }
    SEAM(1);
    if (IN(2)) {
        pg8::Gemm gm{RH, (const bf16_t*)(ws + WS_W2_1), 16384, 2048, 5632}; pg8::StaticOrder S; S.init(16384, 2048, G, c);
        EpiResid E{p.in[0], p.out, RA, (float*)(ws + WS_SS2), 0.5f, 2048};
        pg8::gemm_phase<EpiResid, pg8::StaticOrder, true, true>(lds, gm, S, E);
    }
    SEAM(2);
    if (IN(3)) {
        { pg8::Gemm gm{RA, (const bf16_t*)(ws + WS_WIN), 16384, 5120, 2048}; pg8::StaticOrder S; S.init(16384, 5120, G, c);
          EpiScale E{RH, 5120, (const float*)(ws + WS_SS2)};
          pg8::gemm_phase<EpiScale, pg8::StaticOrder, true, true>(lds, gm, S, E); }
    }
    SEAM(3);
    if (IN(4)) {
        const int cm = (c + 128) % G; const bool split = (G >= 64);
        if (cm < 32) { pg8::Gemm gm{(const bf16_t*)(ws + WS_MEMB), (const bf16_t*)(ws + WS_WMEM), 2048, 1024, 2048}; pg8::StaticOrder S; S.init(2048, 1024, G, cm);
          EpiScale E{(bf16_t*)(ws + WS_MKV), 1024, (const float*)(ws + WS_SSM)};
          pg8::gemm_phase<EpiScale, pg8::StaticOrder, true, true>(lds, gm, S, E);
          pg8::Unit u; if (S.next(0, u)) mem_own_post(p, lds, u.pm, u.pn); }
        if (!split || cm >= 32) post_phase(p, lds, split ? cm - 32 : c, split ? G - 32 : G, true, false);
    }
    SEAM(4);
    if (IN(4) && !IN(5) && IN(6)) xcd_barrier(xbar);
    if (IN(6)) { for (int rep = 0; rep < REP5; ++rep) attn_phase(p, lds, rep); }
    SEAM(6);
    if (IN(7)) {
        pg8::Gemm gm{RA, (const bf16_t*)(ws + WS_WOUT), 16384, 2048, 2048}; pg8::StaticOrder S; S.init(16384, 2048, G, c);
        EpiResid E{p.out, p.out, RB, (float*)(ws + WS_SS3), 1.0f, 2048};
        pg8::gemm_phase<EpiResid, pg8::StaticOrder, true, true>(lds, gm, S, E);
    }
    SEAM(7);
    if (IN(8)) {
        pg8::Gemm gm{RB, (const bf16_t*)(ws + WS_W13_2), 16384, 11264, 2048}; pg8::StaticOrder S; S.init(16384, 11264, G, c);
        EpiSwiGLU E{RH, 5632, (const float*)(ws + WS_SS3)};
        pg8::gemm_phase<EpiSwiGLU, pg8::StaticOrder, true, true>(lds, gm, S, E);
    }
    SEAM(8);
    if (IN(9)) {
        pg8::Gemm gm{RH, (const bf16_t*)(ws + WS_W2_2), 16384, 2048, 5632}; pg8::StaticOrder S; S.init(16384, 2048, G, c);
        EpiResid E{p.out, p.out, nullptr, nullptr, 0.5f, 2048};
        pg8::gemm_phase<EpiResid, pg8::StaticOrder, true, true>(lds, gm, S, E);
    }
#undef IN
#undef SEAM
}

extern "C" void kernel_launch(void* const* d_in, const int* in_sizes, int n_in, void* d_out, int out_size, void* d_ws, size_t ws_size, hipStream_t stream) {
    static int grid = 0;
    if (grid == 0) {
        if (n_in != 23 || out_size != 16384 * 2048 || ws_size < WS_END) { fprintf(stderr, "kernel_launch: unexpected shapes / workspace (n_in %d out %d ws %zu need %zu)\n", n_in, out_size, ws_size, (size_t)WS_END); grid = -1; return; }
        int dev = 0, cus = 0, per_cu = 0;
        if (hipGetDevice(&dev) != hipSuccess || hipDeviceGetAttribute(&cus, hipDeviceAttributeMultiprocessorCount, dev) != hipSuccess) { grid = -1; return; }
        if (hipFuncSetAttribute((const void*)fwd_mega, hipFuncAttributeMaxDynamicSharedMemorySize, LDS_BYTES) != hipSuccess) { fprintf(stderr, "kernel_launch: hipFuncSetAttribute failed\n"); grid = -1; return; }
        if (hipOccupancyMaxActiveBlocksPerMultiprocessor(&per_cu, (const void*)fwd_mega, 512, LDS_BYTES) != hipSuccess || per_cu < 1) { fprintf(stderr, "kernel_launch: occupancy query says %d\n", per_cu); }
        (void)hipGetLastError();
        grid = cus;
    }
    if (grid < 0) return;
    Params p{};
    for (int i = 0; i < 23; ++i) p.in[i] = (const float*)d_in[i];
    p.out = (float*)d_out; p.ws = (unsigned char*)d_ws;
#if ONE_LAUNCH
    p.ph_lo = 0; p.ph_hi = NPHASE;
    void* args[] = {&p};
    if (hipMemsetAsync((unsigned char*)d_ws + WS_BAR, 0, 16384, stream) != hipSuccess) { fprintf(stderr, "kernel_launch: memset of the barrier words failed\n"); return; }
    hipError_t e = hipLaunchCooperativeKernel((const void*)fwd_mega, dim3(grid), dim3(512), args, LDS_BYTES, stream);
    if (e != hipSuccess) fprintf(stderr, "cooperative launch failed: %s (grid %d)\n", hipGetErrorString(e), grid);
#else
    for (int k = 0; k < NPHASE; ++k) { p.ph_lo = k; p.ph_hi = k + 1; hipLaunchKernelGGL(fwd_mega, dim3(grid), dim3(512), LDS_BYTES, stream, p); }
#endif
}
```
